# Optimizing an MI355X kernel written in HIP

```python
import jax, jax.numpy as jnp
from jax import lax
import numpy as np

D_MODEL = 2048
BATCH = 4
SEQ = 2048
DEPTH = 1
DEC_BATCH = 128
DEC_SEQ = 4
PAST_LEN = 16384
PAGE_SIZE = 128

D_CONV = D_MODEL
CONV_WIDTH = 3
POOL_WINDOWS = (2, 4, 8, 16)
N_POOL_GROUPS = len(POOL_WINDOWS)
D_POOL = D_MODEL // 2
D_POOL_GROUP = D_POOL // N_POOL_GROUPS
POOL_BUF = max(POOL_WINDOWS) - 1
D_FF = ((8 * D_MODEL + 3 * 256 - 1) // (3 * 256)) * 256
D_IN = 3 * D_CONV + D_POOL + 2 * D_MODEL
EPS = 1e-6

kernel_name = "gated_shortconv_multiscale_pool_hybrid_step"


def rmsnorm(x, g):
    xf = x.astype(jnp.float32)
    r = lax.rsqrt(jnp.mean(xf * xf, axis=-1, keepdims=True) + EPS)
    return (xf * r).astype(x.dtype) * g


def pool_counts(pos0, T):
    t = jnp.arange(T, dtype=jnp.int32) + pos0
    w = jnp.array(POOL_WINDOWS, dtype=jnp.int32)
    return jnp.minimum(t[:, None] + 1, w[None, :]).astype(jnp.float32)


def causal_multiscale_pool(v_ext, counts):
    T = v_ext.shape[1] - POOL_BUF
    vf = v_ext.astype(jnp.float32)
    cs = jnp.cumsum(vf, axis=1)
    cs0 = jnp.concatenate([jnp.zeros_like(cs[:, :1]), cs], axis=1)
    end = cs0[:, POOL_BUF + 1:]
    outs = []
    for g, w in enumerate(POOL_WINDOWS):
        lo, hi = g * D_POOL_GROUP, (g + 1) * D_POOL_GROUP
        start = cs0[:, POOL_BUF + 1 - w: POOL_BUF + 1 - w + T, lo:hi]
        outs.append((end[..., lo:hi] - start) / counts[None, :, g:g + 1])
    mean = jnp.concatenate(outs, axis=-1)
    return (mean - vf[:, POOL_BUF:]).astype(v_ext.dtype)


def decoder_layer(x, conv_buf, pool_buf, counts, norm_mix, w_in, conv_w, w_pool, pool_scale,
                  w_br_conv, w_br_pool, w_o, norm_ffn, w_gate, w_up, w_down):
    Bsz, T, _ = x.shape
    xn = rmsnorm(x, norm_mix)
    proj = jnp.einsum('btd,de->bte', xn, w_in)
    h, b, c, v, gc, gp = jnp.split(
        proj, [D_CONV, 2 * D_CONV, 3 * D_CONV, 3 * D_CONV + D_POOL, 3 * D_CONV + D_POOL + D_MODEL], axis=-1)
    u_ext = jnp.concatenate([conv_buf, c * h], axis=1)
    conv = conv_w[0] * u_ext[:, 0:T] + conv_w[1] * u_ext[:, 1:T + 1] + conv_w[2] * u_ext[:, 2:T + 2]
    y_conv = jnp.einsum('btc,cd->btd', b * conv, w_br_conv)
    v_ext = jnp.concatenate([pool_buf, v], axis=1)
    pooled = causal_multiscale_pool(v_ext, counts).reshape(Bsz, T, N_POOL_GROUPS, D_POOL_GROUP)
    mixed = jnp.einsum('btgc,gcd->btgd', pooled, w_pool).reshape(Bsz, T, D_POOL) * pool_scale
    y_pool = jnp.einsum('btc,cd->btd', mixed, w_br_pool)
    merged = jax.nn.sigmoid(gc) * y_conv + jax.nn.sigmoid(gp) * y_pool
    x = x + jnp.einsum('btd,de->bte', merged, w_o)
    hn = rmsnorm(x, norm_ffn)
    ff = jax.nn.silu(jnp.einsum('btd,df->btf', hn, w_gate)) * jnp.einsum('btd,df->btf', hn, w_up)
    x = x + jnp.einsum('btf,fd->btd', ff, w_down)
    return x, u_ext[:, -(CONV_WIDTH - 1):], v_ext[:, -POOL_BUF:]


def setup_inputs(seed: int = 0) -> dict:
    key = jax.random.key(seed)
    ks = jax.random.split(key, 20)
    f32 = jnp.float32
    nrm = lambda k, s, sc: jax.random.normal(k, s, f32) * sc
    return {
        "x_prompt": nrm(ks[0], (BATCH, SEQ, D_MODEL), 1.0),
        "x_sample": nrm(ks[1], (DEC_BATCH, DEC_SEQ, D_MODEL), 1.0),
        "state_conv": nrm(ks[2], (DEPTH, DEC_BATCH, CONV_WIDTH - 1, D_CONV), 1.0),
        "state_pool": nrm(ks[3], (DEPTH, DEC_BATCH, POOL_BUF, D_POOL), 1.0),
        "norm_mix": 1.0 + nrm(ks[4], (DEPTH, D_MODEL), 0.1),
        "w_in": nrm(ks[5], (DEPTH, D_MODEL, D_IN), D_MODEL ** -0.5),
        "conv_w": nrm(ks[6], (DEPTH, CONV_WIDTH, D_CONV), CONV_WIDTH ** -0.5),
        "w_pool": nrm(ks[7], (DEPTH, N_POOL_GROUPS, D_POOL_GROUP, D_POOL_GROUP), D_POOL_GROUP ** -0.5),
        "pool_scale": 1.0 + nrm(ks[8], (DEPTH, D_POOL), 0.1),
        "w_br_conv": nrm(ks[9], (DEPTH, D_CONV, D_MODEL), D_CONV ** -0.5),
        "w_br_pool": nrm(ks[10], (DEPTH, D_POOL, D_MODEL), D_POOL ** -0.5),
        "w_o": nrm(ks[11], (DEPTH, D_MODEL, D_MODEL), D_MODEL ** -0.5),
        "norm_ffn": 1.0 + nrm(ks[12], (DEPTH, D_MODEL), 0.1),
        "w_gate": nrm(ks[13], (DEPTH, D_MODEL, D_FF), D_MODEL ** -0.5),
        "w_up": nrm(ks[14], (DEPTH, D_MODEL, D_FF), D_MODEL ** -0.5),
        "w_down": nrm(ks[15], (DEPTH, D_FF, D_MODEL), D_FF ** -0.5),
        "norm_final": 1.0 + nrm(ks[16], (D_MODEL,), 0.1),
    }


def reference(x_prompt, x_sample, state_conv, state_pool, norm_mix, w_in, conv_w, w_pool, pool_scale,
              w_br_conv, w_br_pool, w_o, norm_ffn, w_gate, w_up, w_down, norm_final):
    Bp, Tp, _ = x_prompt.shape
    Ts = x_sample.shape[1]
    counts_p = pool_counts(0, Tp)
    counts_s = pool_counts(PAST_LEN, Ts)
    yp, ys = x_prompt, x_sample
    conv_p, pool_p, conv_s, pool_s = [], [], [], []
    for l in range(DEPTH):
        params = (norm_mix[l], w_in[l], conv_w[l], w_pool[l], pool_scale[l], w_br_conv[l], w_br_pool[l],
                  w_o[l], norm_ffn[l], w_gate[l], w_up[l], w_down[l])
        zc = jnp.zeros((Bp, CONV_WIDTH - 1, D_CONV), x_prompt.dtype)
        zp = jnp.zeros((Bp, POOL_BUF, D_POOL), x_prompt.dtype)
        yp, cp, pp = decoder_layer(yp, zc, zp, counts_p, *params)
        ys, cs_, ps_ = decoder_layer(ys, state_conv[l], state_pool[l], counts_s, *params)
        conv_p.append(cp); pool_p.append(pp); conv_s.append(cs_); pool_s.append(ps_)
    y_prompt = rmsnorm(yp, norm_final)
    y_sample = rmsnorm(ys, norm_final)
    new_conv_prompt = jnp.stack(conv_p, axis=0)
    new_pool_prompt = jnp.stack(pool_p, axis=0)
    new_conv_sample = jnp.stack(conv_s, axis=0)
    new_pool_sample = jnp.stack(pool_s, axis=0)
    return (y_prompt, y_sample, new_conv_prompt, new_pool_prompt, new_conv_sample, new_pool_sample)
```

```cpp
#include <hip/hip_runtime.h>
#include <hip/hip_cooperative_groups.h>
#include <cstdio>
#include <cstdint>
namespace cg = cooperative_groups;

#define LAS __attribute__((address_space(3)))
typedef unsigned short bf16_t;
typedef short bf16x8 __attribute__((ext_vector_type(8)));
typedef float f32x4 __attribute__((ext_vector_type(4)));
typedef unsigned u32x4 __attribute__((ext_vector_type(4)));
typedef unsigned u32x2 __attribute__((ext_vector_type(2)));

constexpr int DM = 2048, MP = 8192, MS = 512, MT = MP + MS, SEQ = 2048, DSEQ = 4, DBATCH = 128, NB = 4;
constexpr int DIN = 11264, DPOOL = 1024, DFF = 5632;
constexpr int C_H = 0, C_B = 2048, C_C = 4096, C_V = 6144, C_GC = 7168, C_GP = 9216;
constexpr float EPS = 1e-6f;
constexpr int NWAVES = 8;
#ifndef REP0
#define REP0 1
#endif
#ifndef REP1
#define REP1 1
#endif
#ifndef REP3
#define REP3 1
#endif
#ifndef REP4
#define REP4 1
#endif
#ifndef REP6
#define REP6 1
#endif
#ifndef REP2
#define REP2 1
#endif
#ifndef REP5
#define REP5 1
#endif
#ifndef REP7
#define REP7 1
#endif
#ifndef REP8
#define REP8 1
#endif
#ifndef REPS
#define REPS 1
#endif

constexpr size_t MiB = 1u << 20;
constexpr size_t WS_CTL = 0;
constexpr size_t WS_BAR = 256 * 1024, CTL_ZERO_BYTES = 512 * 1024;
constexpr size_t WS_WIN = 1 * MiB;
constexpr size_t WS_WGU = 45 * MiB;
constexpr size_t WS_WDN = 89 * MiB;
constexpr size_t WS_WBC = 111 * MiB;
constexpr size_t WS_WO = 119 * MiB;
constexpr size_t WS_WBP = 127 * MiB;
constexpr size_t WS_WPL = 131 * MiB;
constexpr size_t WS_XN = 132 * MiB;
constexpr size_t WS_U = 166 * MiB;
constexpr size_t WS_B = 200 * MiB;
constexpr size_t WS_V = 234 * MiB;
constexpr size_t WS_PO = 251 * MiB;
constexpr size_t WS_SGC = 268 * MiB;
constexpr size_t WS_SGP = 302 * MiB;
constexpr size_t WS_END = 336 * MiB;
constexpr size_t WS_FF = WS_U;
static_assert(WS_FF + (size_t)MT * DFF * 2 <= WS_SGC, "FF overlay");
static_assert(WS_V == WS_B + 34 * MiB && WS_SGC == WS_B + 68 * MiB && WS_SGP == WS_B + 102 * MiB, "EpiG1 region arithmetic");

constexpr int RING_BYTES = 131072, LDS_BYTES = 147456;

__device__ __forceinline__ unsigned cvt_pk_bf16(float lo, float hi) { unsigned r; asm volatile("v_cvt_pk_bf16_f32 %0, %1, %2" : "=v"(r) : "v"(lo), "v"(hi)); return r; }
__device__ __forceinline__ u32x4 pack8(f32x4 a, f32x4 b) { u32x4 w; w.x = cvt_pk_bf16(a[0], a[1]); w.y = cvt_pk_bf16(a[2], a[3]); w.z = cvt_pk_bf16(b[0], b[1]); w.w = cvt_pk_bf16(b[2], b[3]); return w; }
__device__ __forceinline__ f32x4 unpack_lo(u32x4 w) { return (f32x4){__uint_as_float(w.x << 16), __uint_as_float(w.x & 0xffff0000u), __uint_as_float(w.y << 16), __uint_as_float(w.y & 0xffff0000u)}; }
__device__ __forceinline__ f32x4 unpack_hi(u32x4 w) { return (f32x4){__uint_as_float(w.z << 16), __uint_as_float(w.z & 0xffff0000u), __uint_as_float(w.w << 16), __uint_as_float(w.w & 0xffff0000u)}; }
__device__ __forceinline__ float bf2f(bf16_t b) { return __uint_as_float(((unsigned)b) << 16); }
__device__ __forceinline__ float sigm(float x) { return __builtin_amdgcn_rcpf(1.0f + __builtin_amdgcn_exp2f(-1.44269504f * x)); }
__device__ __forceinline__ f32x4 sigm4(f32x4 v) { return (f32x4){sigm(v[0]), sigm(v[1]), sigm(v[2]), sigm(v[3])}; }
__device__ __forceinline__ float dot4(f32x4 v) { return (v[0] * v[0] + v[1] * v[1]) + (v[2] * v[2] + v[3] * v[3]); }

namespace pg8 {
constexpr int BM = 256, BK = 64, HALF = 128, HTB = HALF * BK * 2, STAGE_BYTES = 8 * HTB, NXCD = 8, WGM = 8;
__host__ __device__ __forceinline__ int lds_byte(int r, int c) { const int st = (r >> 4) * 2 + (c >> 5), rr = r & 15, cc = c & 31, ob = rr * 64 + cc * 2; return st * 1024 + (ob ^ (((ob >> 9) & 1) << 5)); }
__host__ __device__ __forceinline__ void stage_rc(int b, int& R, int& C) { const int st = b / 1024, sb = b % 1024, swz = sb ^ (((sb >> 9) & 1) << 5); R = (st >> 1) * 16 + swz / 64; C = (st & 1) * 32 + (swz % 64) / 2; }
__host__ __device__ __forceinline__ int perm32(int rho) { const int n = rho >> 4, i = rho & 15; return 8 * (i >> 2) + 4 * n + (i & 3); }

struct Unit { int pm, pn; unsigned kofs; };
struct Gemm { const bf16_t* A; const bf16_t* Bt; int lda, ldb, K, a_koff; };

struct StaticOrder {
    int nM, nN, nwg, G, c;
    __host__ __device__ void init(int M, int N, int G_, int c_) { nM = M / BM; nN = N / BM; nwg = nM * nN; G = G_; c = c_; }
    __host__ __device__ bool next(int i, Unit& u) const {
        const long L = (long)i * G + c; if (L >= nwg) return false;
        int wgid = (int)L; { const int q = nwg / NXCD, r = nwg % NXCD, xcd = wgid % NXCD, off = wgid / NXCD; wgid = (xcd < r ? xcd * (q + 1) : r * (q + 1) + (xcd - r) * q) + off; }
        const int nig = WGM * nN, gid = wgid / nig, fm = gid * WGM, gsz = (nM - fm) < WGM ? (nM - fm) : WGM;
        u.pm = fm + ((wgid % nig) % gsz); u.pn = (wgid % nig) / gsz; u.kofs = 0u; return true;
    }
    __device__ __forceinline__ void a_ready(const Unit&) const {}
    __device__ __forceinline__ void done(const Unit&) const {}
};

struct SplitKOrder {
    int G, c, nsl, pm0; unsigned slice_bytes;
    __device__ __forceinline__ bool next(int i, Unit& u) const { const int L = i * G + c; if (L >= 16 * nsl) return false; const int sl = L >> 4, q = L & 15; u.pm = pm0 + (q >> 3); u.pn = q & 7; u.kofs = (unsigned)sl * slice_bytes; return true; }
    __device__ __forceinline__ void a_ready(const Unit&) const {}
    __device__ __forceinline__ void done(const Unit&) const {}
};
template <class Epi, class Sched>
__device__ __forceinline__ void gemm_phase(LAS unsigned char* lds, const Gemm g, const Sched& S, const Epi& E) {
    int tid = threadIdx.x; asm volatile("" : "+v"(tid));
    const int wid = __builtin_amdgcn_readfirstlane(tid >> 6), lane = tid & 63, wr = wid >> 2, wc = wid & 3, fr = lane & 15, fq = lane >> 4;
    const int K = g.K, nt = K / BK;
    unsigned voffA, voffB;
    { int R, C; stage_rc(tid * 16, R, C); const int Rb = (R & ~31) + perm32(R & 31); voffA = (unsigned)(R * g.lda + C) * 2u; voffB = (unsigned)(Rb * g.ldb + C) * 2u; }
    const size_t kstep = (size_t)(BK * 2);
    const size_t hstepA = (size_t)HALF * g.lda * 2, hstepB = (size_t)HALF * g.ldb * 2;
    const size_t tstepA = 2 * hstepA, tstepB = 2 * hstepB, qstepA = hstepA / 2, qstepB = hstepB / 2;
    struct voffA_tag_t { char c; }; struct voffB_tag_t { char c[2]; }; typedef voffA_tag_t voffA_tag; typedef voffB_tag_t voffB_tag;
    const unsigned ldsw = (unsigned)wid * 1024u;
    const int aoff = lds_byte(wr * 64 + fr, fq * 8), boff = lds_byte(wc * 32 + fr, fq * 8);
#define PG8_SA(b, h) (((b) * 2 + (h)) * HTB)
#define PG8_SB(b, h) ((4 + (b) * 2 + (h)) * HTB)
#define PG8_STAGE(bufoff, gbase, voff) do { _Pragma("unroll") for (int _i = 0; _i < 2; ++_i) \
        __builtin_amdgcn_global_load_lds((const unsigned*)((const char*)(gbase) + (size_t)_i * (sizeof(voff##_tag) == 1 ? qstepA : qstepB) + (voff)), (LAS unsigned*)(lds + (bufoff) + ldsw + _i * 8192), 16, 0, 0); } while (0)
#define PG8_LDA(dst, b, h) do { _Pragma("unroll") for (int m = 0; m < 4; ++m) _Pragma("unroll") for (int k = 0; k < 2; ++k) dst[m][k] = *(const LAS bf16x8*)(lds + PG8_SA(b, h) + aoff + m * 2048 + k * 1024); } while (0)
#define PG8_LDB(dst, b, h) do { _Pragma("unroll") for (int n = 0; n < 2; ++n) _Pragma("unroll") for (int k = 0; k < 2; ++k) dst[n][k] = *(const LAS bf16x8*)(lds + PG8_SB(b, h) + boff + n * 2048 + k * 1024); } while (0)
#define PG8_MMA(ai, bj, At, Bt) do { __builtin_amdgcn_s_setprio(1); _Pragma("unroll") for (int m = 0; m < 4; ++m) _Pragma("unroll") for (int n = 0; n < 2; ++n) _Pragma("unroll") for (int k = 0; k < 2; ++k) \
        acc[ai][bj][m][n] = __builtin_amdgcn_mfma_f32_16x16x32_bf16(Bt[n][k], At[m][k], acc[ai][bj][m][n], 0, 0, 0); __builtin_amdgcn_s_setprio(0); } while (0)
#define PG8_WAIT_V(n) asm volatile("s_waitcnt vmcnt(" #n ")" ::: "memory")
#define PG8_WAIT_L(n) asm volatile("s_waitcnt lgkmcnt(" #n ")" ::: "memory")
#define PG8_BAR __builtin_amdgcn_s_barrier()
#define PG8_SCHED __builtin_amdgcn_sched_barrier(0)
    Unit cur, nxt; int ui = 0;
    if (!S.next(0, cur)) return;
    f32x4 acc[2][2][4][2];
#pragma unroll
    for (int a = 0; a < 2; ++a)
#pragma unroll
        for (int b = 0; b < 2; ++b)
#pragma unroll
            for (int m = 0; m < 4; ++m)
#pragma unroll
                for (int n = 0; n < 2; ++n) acc[a][b][m][n] = (f32x4){0.f, 0.f, 0.f, 0.f};
    bf16x8 At[4][2], B0[2][2], B1[2][2];
    const char* cA = (const char*)g.A + (size_t)cur.pm * tstepA + (size_t)cur.pn * g.a_koff * 2 + cur.kofs; const char* cB = (const char*)g.Bt + (size_t)cur.pn * tstepB + cur.kofs;
    S.a_ready(cur);
    PG8_STAGE(PG8_SB(0, 0), cB, voffB); PG8_STAGE(PG8_SB(0, 1), cB + hstepB, voffB); PG8_STAGE(PG8_SA(0, 0), cA, voffA); PG8_STAGE(PG8_SA(0, 1), cA + hstepA, voffA);
    if (wr == 1) PG8_BAR;
    PG8_WAIT_V(2); PG8_BAR;
    PG8_STAGE(PG8_SB(1, 0), cB + kstep, voffB); PG8_STAGE(PG8_SA(1, 0), cA + kstep, voffA); PG8_STAGE(PG8_SB(1, 1), cB + hstepB + kstep, voffB);
    PG8_WAIT_V(6); PG8_BAR;
    for (;;) {
        const bool has_next = S.next(ui + 1, nxt);
        const char* nA = has_next ? (const char*)g.A + (size_t)nxt.pm * tstepA + (size_t)nxt.pn * g.a_koff * 2 + nxt.kofs : cA; const char* nB = has_next ? (const char*)g.Bt + (size_t)nxt.pn * tstepB + nxt.kofs : cB;
        for (int t = 0; t < nt; t += 2) {
            const bool last = (t == nt - 2);
            const char* a1 = cA + (size_t)(t + 1) * kstep;
            const char* a2 = last ? nA : cA + (size_t)(t + 2) * kstep; const char* b2 = last ? nB : cB + (size_t)(t + 2) * kstep;
            const char* a3 = a2 + kstep; const char* b3 = b2 + kstep;
            if (last && has_next) S.a_ready(nxt);
            PG8_LDB(B0, 0, 0); PG8_LDB(B1, 0, 1); PG8_SCHED; PG8_LDA(At, 0, 0); PG8_STAGE(PG8_SA(1, 1), a1 + hstepA, voffA);
            PG8_WAIT_V(8); PG8_WAIT_L(0); PG8_BAR; PG8_MMA(0, 0, At, B0); PG8_MMA(0, 1, At, B1); PG8_BAR; PG8_SCHED;
            PG8_LDA(At, 0, 1); PG8_STAGE(PG8_SB(0, 0), b2, voffB); PG8_STAGE(PG8_SB(0, 1), b2 + hstepB, voffB); PG8_STAGE(PG8_SA(0, 0), a2, voffA);
            PG8_WAIT_V(8); PG8_WAIT_L(0); PG8_BAR; PG8_MMA(1, 0, At, B0); PG8_MMA(1, 1, At, B1); PG8_BAR; PG8_SCHED;
            PG8_LDB(B0, 1, 0); PG8_LDB(B1, 1, 1); PG8_SCHED; PG8_LDA(At, 1, 0); PG8_STAGE(PG8_SA(0, 1), a2 + hstepA, voffA);
            PG8_WAIT_V(8); PG8_WAIT_L(0); PG8_BAR; PG8_MMA(0, 0, At, B0); PG8_MMA(0, 1, At, B1); PG8_BAR; PG8_SCHED;
            PG8_LDA(At, 1, 1); PG8_STAGE(PG8_SB(1, 0), b3, voffB); PG8_STAGE(PG8_SB(1, 1), b3 + hstepB, voffB); PG8_STAGE(PG8_SA(1, 0), a3, voffA);
            PG8_WAIT_V(8); PG8_WAIT_L(0); PG8_BAR; PG8_MMA(1, 0, At, B0); PG8_MMA(1, 1, At, B1); PG8_BAR; PG8_SCHED;
        }
        if (wr == 0) PG8_BAR;
        E(acc, cur, wr, wc, fr, fq); S.done(cur);
        if (!has_next) break;
#pragma unroll
        for (int a = 0; a < 2; ++a)
#pragma unroll
            for (int b = 0; b < 2; ++b)
#pragma unroll
                for (int m = 0; m < 4; ++m)
#pragma unroll
                    for (int n = 0; n < 2; ++n) acc[a][b][m][n] = (f32x4){0.f, 0.f, 0.f, 0.f};
        cur = nxt; cA = nA; cB = nB; ++ui;
        if (wr == 1) PG8_BAR;
    }
    PG8_WAIT_V(0);
    PG8_BAR;
#undef PG8_SA
#undef PG8_SB
#undef PG8_STAGE
#undef PG8_LDA
#undef PG8_LDB
#undef PG8_MMA
#undef PG8_WAIT_V
#undef PG8_WAIT_L
#undef PG8_BAR
#undef PG8_SCHED
}
}
using pg8::Unit; using pg8::BM; using pg8::HALF;

typedef const f32x4 (&AccRef)[2][2][4][2];
struct EpiG1 {
    bf16_t *U, *Bb;
    __device__ __forceinline__ void operator()(AccRef acc, const Unit& u, int wr, int wc, int fr, int fq) const {
        const int row0 = u.pm * BM + wr * 64 + fr, cw = wc * 32 + 8 * fq;
        if (u.pn < 16) {
#pragma unroll
            for (int ai = 0; ai < 2; ++ai)
#pragma unroll
                for (int m = 0; m < 4; ++m) { bf16_t* rowp = U + (size_t)(row0 + ai * HALF + m * 16) * DM + u.pn * 128 + cw;
                    *(u32x4*)rowp = pack8(acc[ai][0][m][0] * acc[ai][1][m][0], acc[ai][0][m][1] * acc[ai][1][m][1]); }
        } else {
            const int g24 = u.pn >= 24, g28 = u.pn >= 28, g36 = u.pn >= 36, ridx = g24 + g28 + g36;
            bf16_t* base = (bf16_t*)((unsigned char*)Bb + (size_t)ridx * (34 * MiB));
            const int ldc = (ridx == 1) ? DPOOL : DM, colt = (u.pn - (16 + 8 * g24 + 4 * g28 + 8 * g36)) * 256; const bool sg = ridx >= 2;
#pragma unroll
            for (int ai = 0; ai < 2; ++ai)
#pragma unroll
                for (int m = 0; m < 4; ++m) { bf16_t* rowp = base + (size_t)(row0 + ai * HALF + m * 16) * ldc + colt + cw;
#pragma unroll
                    for (int bj = 0; bj < 2; ++bj) { f32x4 v0 = acc[ai][bj][m][0], v1 = acc[ai][bj][m][1];
                        if (sg) { v0 = sigm4(v0); v1 = sigm4(v1); }
                        *(u32x4*)(rowp + bj * HALF) = pack8(v0, v1); } }
        }
    }
};
struct EpiPool {
    bf16_t* MX; const float* ps;
    __device__ __forceinline__ void operator()(AccRef acc, const Unit& u, int wr, int wc, int fr, int fq) const {
        const int row0 = u.pm * BM + wr * 64 + fr, c0 = u.pn * 256 + wc * 32 + 8 * fq;
        f32x4 s[2][2];
#pragma unroll
        for (int bj = 0; bj < 2; ++bj) { s[bj][0] = *(const f32x4*)(ps + c0 + bj * HALF); s[bj][1] = *(const f32x4*)(ps + c0 + bj * HALF + 4); }
#pragma unroll
        for (int ai = 0; ai < 2; ++ai)
#pragma unroll
            for (int m = 0; m < 4; ++m) { bf16_t* rowp = MX + (size_t)(row0 + ai * HALF + m * 16) * DPOOL + c0;
#pragma unroll
                for (int bj = 0; bj < 2; ++bj) *(u32x4*)(rowp + bj * HALF) = pack8(acc[ai][bj][m][0] * s[bj][0], acc[ai][bj][m][1] * s[bj][1]); }
    }
};
template <bool SECOND> struct EpiMerge {
    const bf16_t* SG; bf16_t* MG;
    __device__ __forceinline__ void operator()(AccRef acc, const Unit& u, int wr, int wc, int fr, int fq) const {
        const int row0 = u.pm * BM + wr * 64 + fr, c0 = u.pn * 256 + wc * 32 + 8 * fq;
#pragma unroll
        for (int ai = 0; ai < 2; ++ai)
#pragma unroll
            for (int m = 0; m < 4; ++m) { const size_t off = (size_t)(row0 + ai * HALF + m * 16) * DM + c0;
#pragma unroll
                for (int bj = 0; bj < 2; ++bj) { const u32x4 g = *(const u32x4*)(SG + off + bj * HALF);
                    f32x4 v0 = unpack_lo(g) * acc[ai][bj][m][0], v1 = unpack_hi(g) * acc[ai][bj][m][1];
                    if (SECOND) { const u32x4 o = *(const u32x4*)(MG + off + bj * HALF); v0 += unpack_lo(o); v1 += unpack_hi(o); }
                    *(u32x4*)(MG + off + bj * HALF) = pack8(v0, v1); }
                asm volatile("" ::: "memory"); }
    }
};
template <bool FIRST> struct EpiRes {
    const float* xp; const float* xs; const float* gf; bf16_t* XB; bf16_t* XG; float* ssq;
    __device__ __forceinline__ void operator()(AccRef acc, const Unit& u, int wr, int wc, int fr, int fq) const {
        const int row0 = u.pm * BM + wr * 64 + fr, c0 = u.pn * 256 + wc * 32 + 8 * fq;
        const float* xbase = (u.pm < MP / BM) ? xp : xs - (size_t)MP * DM;
#pragma unroll
        for (int ai = 0; ai < 2; ++ai)
#pragma unroll
            for (int m = 0; m < 4; ++m) { const int row = row0 + ai * HALF + m * 16; const size_t off = (size_t)row * DM + c0; float s = 0.f;
#pragma unroll
                for (int bj = 0; bj < 2; ++bj) { f32x4 xa, xb;
                    if (FIRST) { xa = __builtin_nontemporal_load((const f32x4*)(xbase + off + bj * HALF)); xb = __builtin_nontemporal_load((const f32x4*)(xbase + off + bj * HALF + 4)); }
                    else { const u32x4 w = *(const u32x4*)(XB + off + bj * HALF); xa = unpack_lo(w); xb = unpack_hi(w); }
                    const f32x4 v0 = xa + acc[ai][bj][m][0], v1 = xb + acc[ai][bj][m][1];
                    *(u32x4*)(XB + off + bj * HALF) = pack8(v0, v1);
                    s += dot4(v0) + dot4(v1);
                    if (FIRST) { const f32x4 g0 = *(const f32x4*)(gf + c0 + bj * HALF), g1 = *(const f32x4*)(gf + c0 + bj * HALF + 4);
                        *(u32x4*)(XG + off + bj * HALF) = pack8(v0 * g0, v1 * g1); } }
                s += __shfl_xor(s, 16); s += __shfl_xor(s, 32);
                if (fq == 0) atomicAdd(ssq + row, s);
                asm volatile("" ::: "memory"); }
    }
};
struct EpiPart {
    float* PART; unsigned slice_bytes;
    __device__ __forceinline__ void operator()(AccRef acc, const Unit& u, int wr, int wc, int fr, int fq) const {
        const int row0 = (u.pm - MP / BM) * BM + wr * 64 + fr, c0 = u.pn * 256 + wc * 32 + 8 * fq;
        float* base = PART + (size_t)(u.kofs / slice_bytes) * MS * DM;
#pragma unroll
        for (int ai = 0; ai < 2; ++ai)
#pragma unroll
            for (int m = 0; m < 4; ++m) { float* rp = base + (size_t)(row0 + ai * HALF + m * 16) * DM + c0;
#pragma unroll
                for (int bj = 0; bj < 2; ++bj) { *(f32x4*)(rp + bj * HALF) = acc[ai][bj][m][0]; *(f32x4*)(rp + bj * HALF + 4) = acc[ai][bj][m][1]; } }
    }
};
struct EpiFF {
    bf16_t* FF; const float* ssq;
    __device__ __forceinline__ void operator()(AccRef acc, const Unit& u, int wr, int wc, int fr, int fq) const {
        const int row0 = u.pm * BM + wr * 64 + fr, c0 = u.pn * 128 + wc * 32 + 8 * fq;
#pragma unroll
        for (int ai = 0; ai < 2; ++ai)
#pragma unroll
            for (int m = 0; m < 4; ++m) { const int row = row0 + ai * HALF + m * 16;
                const float r = 1.0f / sqrtf(ssq[row] * (1.0f / DM) + EPS);
                f32x4 o[2];
#pragma unroll
                for (int n = 0; n < 2; ++n) { const f32x4 g = acc[ai][0][m][n] * r, uu = acc[ai][1][m][n] * r; o[n] = g * sigm4(g) * uu; }
                *(u32x4*)(FF + (size_t)row * DFF + c0) = pack8(o[0], o[1]); }
    }
};


__device__ __forceinline__ void mini_gemm(LAS unsigned char* lds, const bf16_t* A, int lda, const bf16_t* Bt, int ldb, int K, int row0, int col0, f32x4& v0, f32x4& v1) {
    int tid = threadIdx.x; asm volatile("" : "+v"(tid));
    const int wid = __builtin_amdgcn_readfirstlane(tid >> 6), lane = tid & 63, fr = lane & 15, fq = lane >> 4;
    const int ks = K >> 3, kbeg = wid * ks;
    f32x4 acc[4][4];
#pragma unroll
    for (int m = 0; m < 4; ++m)
#pragma unroll
        for (int n = 0; n < 4; ++n) acc[m][n] = (f32x4){0.f, 0.f, 0.f, 0.f};
    const bf16_t* ap = A + (size_t)(row0 + fr) * lda + kbeg + fq * 8;
    const bf16_t* bp = Bt + (size_t)(col0 + fr) * ldb + kbeg + fq * 8;
#define MINI_LOAD(s_, kk_) do { _Pragma("unroll") for (int m = 0; m < 4; ++m) { a[s_][m][0] = *(const bf16x8*)(ap + (size_t)(m * 16) * lda + (kk_)); a[s_][m][1] = *(const bf16x8*)(ap + (size_t)(m * 16) * lda + (kk_) + 32); } \
        _Pragma("unroll") for (int n = 0; n < 4; ++n) { b[s_][n][0] = *(const bf16x8*)(bp + (size_t)(n * 16) * ldb + (kk_)); b[s_][n][1] = *(const bf16x8*)(bp + (size_t)(n * 16) * ldb + (kk_) + 32); } } while (0)
#define MINI_MMA(s_) do { _Pragma("unroll") for (int h = 0; h < 2; ++h) _Pragma("unroll") for (int m = 0; m < 4; ++m) _Pragma("unroll") for (int n = 0; n < 4; ++n) \
        acc[m][n] = __builtin_amdgcn_mfma_f32_16x16x32_bf16(b[s_][n][h], a[s_][m][h], acc[m][n], 0, 0, 0); } while (0)
    bf16x8 a[2][4][2], b[2][4][2];
    const int nst = ks >> 6;
    MINI_LOAD(0, 0); MINI_LOAD(1, 64);
    for (int i = 0; i < nst; i += 2) {
#pragma unroll
        for (int s_ = 0; s_ < 2; ++s_) {
            if (i + s_ < nst) { MINI_MMA(s_); if (i + s_ + 2 < nst) MINI_LOAD(s_, (i + s_ + 2) * 64); }
            __builtin_amdgcn_sched_barrier(0);
        }
    }
#undef MINI_LOAD
#undef MINI_MMA
    LAS float* P = (LAS float*)lds + wid * 4096;
#pragma unroll
    for (int m = 0; m < 4; ++m)
#pragma unroll
        for (int n = 0; n < 4; ++n) *(LAS f32x4*)(P + (16 * m + fr) * 64 + 16 * n + 4 * fq) = acc[m][n];
    __syncthreads();
    const LAS float* Q = (const LAS float*)lds + (tid >> 3) * 64 + (tid & 7) * 8;
    v0 = *(const LAS f32x4*)Q; v1 = *(const LAS f32x4*)(Q + 4);
#pragma unroll
    for (int w = 1; w < 8; ++w) { v0 += *(const LAS f32x4*)(Q + w * 4096); v1 += *(const LAS f32x4*)(Q + w * 4096 + 4); }
    __syncthreads();
}

struct Params {
    const float* x_prompt; const float* x_sample; const float* state_conv; const float* state_pool; const float* norm_mix; const float* w_in; const float* conv_w;
    const float* w_pool; const float* pool_scale; const float* w_br_conv; const float* w_br_pool; const float* w_o; const float* norm_ffn; const float* w_gate;
    const float* w_up; const float* w_down; const float* norm_final; float* out; unsigned char* ws;
};

__device__ __forceinline__ float wave_sum(float v) {
#pragma unroll
    for (int o = 1; o < 64; o <<= 1) v += __shfl_xor(v, o);
    return v;
}
__device__ __forceinline__ void transpose_item(const float* W, int ldw, int k0, int nsrc, bf16_t* WT, int Kd, int rdst, LAS float* scr, int lane) {
#pragma unroll 8
    for (int i = 0; i < 32; ++i) { const int kk = 2 * i + (lane >> 5); scr[kk * 33 + (lane & 31)] = __builtin_nontemporal_load(W + (size_t)(k0 + kk) * ldw + nsrc + (lane & 31)); }
    asm volatile("s_waitcnt lgkmcnt(0)" ::: "memory");
    const int c = lane & 7;
#pragma unroll
    for (int j = 0; j < 4; ++j) { const int n = (lane >> 3) + 8 * j; const LAS float* s = scr + (8 * c) * 33 + n;
        u32x4 o; o.x = cvt_pk_bf16(s[0 * 33], s[1 * 33]); o.y = cvt_pk_bf16(s[2 * 33], s[3 * 33]); o.z = cvt_pk_bf16(s[4 * 33], s[5 * 33]); o.w = cvt_pk_bf16(s[6 * 33], s[7 * 33]);
        *(u32x4*)(WT + (size_t)(rdst + n) * Kd + k0 + 8 * c) = o; }
    asm volatile("s_waitcnt lgkmcnt(0)" ::: "memory");
}

#define FRESH_IDS int tid_ = threadIdx.x; asm volatile("" : "+v"(tid_)); const int lane = tid_ & 63, wave = __builtin_amdgcn_readfirstlane(tid_ >> 6); \
    const int G_ = gridDim.x, bx_ = blockIdx.x, vcu_ = (G_ % 8 == 0) ? (bx_ % 8) * (G_ / 8) + bx_ / 8 : bx_, gw = vcu_ * NWAVES + wave, NGW = G_ * NWAVES; (void)wave; (void)lane
__device__ __forceinline__ void phase0(const Params& p, LAS unsigned char* lds) {
    FRESH_IDS;
    LAS float* scr = (LAS float*)(lds + wave * 16384);
    unsigned char* ws = p.ws;
    constexpr int I_IN = (DM / 64) * (DIN / 32), I_GU = I_IN, I_DN = (DFF / 64) * (DM / 32), I_BC = (DM / 64) * (DM / 32), I_O = I_BC, I_BP = (DPOOL / 64) * (DM / 32), I_PL = 4 * 4 * 8;
    constexpr int NITEMS = I_IN + I_GU + I_DN + I_BC + I_O + I_BP + I_PL;
    for (int it = gw; it < NITEMS; it += NGW) {
        int r = it;
        if (r < I_IN) { const int nblk = DIN / 32, kb = r / nblk, nd = (r % nblk) * 32;
            int ns; if (nd < 4096) { const int tile = nd >> 8, half = (nd >> 7) & 1, idx = nd & 127; ns = (half ? C_C : C_H) + 128 * tile + idx; } else if (nd < 6144) ns = nd - 2048; else ns = nd;
            transpose_item(p.w_in, DIN, kb * 64, ns, (bf16_t*)(ws + WS_WIN), DM, nd, scr, lane); continue; }
        r -= I_IN;
        if (r < I_GU) { const int nblk = DIN / 32, kb = r / nblk, nd = (r % nblk) * 32; const int tile = nd >> 8, half = (nd >> 7) & 1, idx = nd & 127;
            transpose_item(half ? p.w_up : p.w_gate, DFF, kb * 64, 128 * tile + idx, (bf16_t*)(ws + WS_WGU), DM, nd, scr, lane); continue; }
        r -= I_GU;
        if (r < I_DN) { const int nblk = DM / 32, kb = r / nblk, nd = (r % nblk) * 32; transpose_item(p.w_down, DM, kb * 64, nd, (bf16_t*)(ws + WS_WDN), DFF, nd, scr, lane); continue; }
        r -= I_DN;
        if (r < I_BC) { const int nblk = DM / 32, kb = r / nblk, nd = (r % nblk) * 32; transpose_item(p.w_br_conv, DM, kb * 64, nd, (bf16_t*)(ws + WS_WBC), DM, nd, scr, lane); continue; }
        r -= I_BC;
        if (r < I_O) { const int nblk = DM / 32, kb = r / nblk, nd = (r % nblk) * 32; transpose_item(p.w_o, DM, kb * 64, nd, (bf16_t*)(ws + WS_WO), DM, nd, scr, lane); continue; }
        r -= I_O;
        if (r < I_BP) { const int nblk = DM / 32, kb = r / nblk, nd = (r % nblk) * 32; transpose_item(p.w_br_pool, DM, kb * 64, nd, (bf16_t*)(ws + WS_WBP), DPOOL, nd, scr, lane); continue; }
        r -= I_BP;
        { const int g = r / 32, q = r % 32, kb = q / 8, nd = (q % 8) * 32; transpose_item(p.w_pool + (size_t)g * 65536, 256, kb * 64, nd, (bf16_t*)(ws + WS_WPL) + (size_t)g * 65536, 256, nd, scr, lane); }
    }
    bf16_t* XN = (bf16_t*)(ws + WS_XN);
    for (int row = gw; row < MT; row += NGW) {
        const float* xr = (row < MP) ? p.x_prompt + (size_t)row * DM : p.x_sample + (size_t)(row - MP) * DM;
        f32x4 v[8]; float s = 0.f;
#pragma unroll
        for (int j = 0; j < 8; ++j) { v[j] = __builtin_nontemporal_load((const f32x4*)xr + 64 * j + lane); s += dot4(v[j]); }
        const float rr = 1.0f / sqrtf(wave_sum(s) * (1.0f / DM) + EPS);
#pragma unroll
        for (int j = 0; j < 8; ++j) { const f32x4 g = ((const f32x4*)p.norm_mix)[64 * j + lane]; const f32x4 o = v[j] * rr * g;
            u32x2 w; w.x = cvt_pk_bf16(o[0], o[1]); w.y = cvt_pk_bf16(o[2], o[3]); ((u32x2*)(XN + (size_t)row * DM))[64 * j + lane] = w; }
    }
}

__device__ __forceinline__ void phase2(const Params& p, const bool st) {
    FRESH_IDS;
    unsigned char* ws = p.ws;
    const bf16_t* U = (const bf16_t*)(ws + WS_U); bf16_t* Bb = (bf16_t*)(ws + WS_B); const bf16_t* V = (const bf16_t*)(ws + WS_V); bf16_t* PO = (bf16_t*)(ws + WS_PO);
    const f32x4 z4 = (f32x4){0.f, 0.f, 0.f, 0.f};
    constexpr int SEG = 32, NSEG = MP / SEG, NPT = NSEG * 6;
    for (int task = gw; task < NPT; task += NGW) {
        const int seg = task / 6, ch = task % 6, r0 = seg * SEG, t0 = r0 % SEQ;
        if (ch < 4) {
            const int j = ch * 512 + lane * 8;
            const float* cw = p.conv_w + j;
            const f32x4 c0a = *(const f32x4*)cw, c0b = *(const f32x4*)(cw + 4), c1a = *(const f32x4*)(cw + DM), c1b = *(const f32x4*)(cw + DM + 4), c2a = *(const f32x4*)(cw + 2 * DM), c2b = *(const f32x4*)(cw + 2 * DM + 4);
            f32x4 u1a = z4, u1b = z4, u2a = z4, u2b = z4;
            if (t0 >= 2) { const u32x4 w1 = *(const u32x4*)(U + (size_t)(r0 - 1) * DM + j), w2 = *(const u32x4*)(U + (size_t)(r0 - 2) * DM + j); u1a = unpack_lo(w1); u1b = unpack_hi(w1); u2a = unpack_lo(w2); u2b = unpack_hi(w2); }
            for (int i = 0; i < SEG; i += 4) {
                u32x4 uw[4], bw[4];
#pragma unroll
                for (int q = 0; q < 4; ++q) { uw[q] = __builtin_nontemporal_load((const u32x4*)(U + (size_t)(r0 + i + q) * DM + j)); bw[q] = __builtin_nontemporal_load((const u32x4*)(Bb + (size_t)(r0 + i + q) * DM + j)); }
#pragma unroll
                for (int q = 0; q < 4; ++q) { const f32x4 u0a = unpack_lo(uw[q]), u0b = unpack_hi(uw[q]);
                    const f32x4 ra = unpack_lo(bw[q]) * (c0a * u2a + c1a * u1a + c2a * u0a), rb = unpack_hi(bw[q]) * (c0b * u2b + c1b * u1b + c2b * u0b);
                    if (st) *(u32x4*)(Bb + (size_t)(r0 + i + q) * DM + j) = pack8(ra, rb);
                    u2a = u1a; u2b = u1b; u1a = u0a; u1b = u0b; }
            }
        } else {
            const int j = (ch - 4) * 512 + lane * 8, g = j >> 8, w = 2 << g;
            f32x4 sa = z4, sb = z4;
            for (int k = 1; k < 16; ++k) if (k < w && t0 - k >= 0) { const u32x4 x = *(const u32x4*)(V + (size_t)(r0 - k) * DPOOL + j); sa += unpack_lo(x); sb += unpack_hi(x); }
            for (int i = 0; i < SEG; i += 4) {
                u32x4 vw[4], ow[4];
#pragma unroll
                for (int q = 0; q < 4; ++q) { const int t = t0 + i + q; vw[q] = *(const u32x4*)(V + (size_t)(r0 + i + q) * DPOOL + j);
                    ow[q] = (t - w + 1 >= 0) ? *(const u32x4*)(V + (size_t)(r0 + i + q - w + 1) * DPOOL + j) : (u32x4){0u, 0u, 0u, 0u}; }
#pragma unroll
                for (int q = 0; q < 4; ++q) { const int t = t0 + i + q; const f32x4 va = unpack_lo(vw[q]), vb = unpack_hi(vw[q]);
                    sa += va; sb += vb;
                    const float inv = 1.0f / (float)((t + 1) < w ? (t + 1) : w);
                    if (st) *(u32x4*)(PO + (size_t)(r0 + i + q) * DPOOL + j) = pack8(sa * inv - va, sb * inv - vb);
                    sa -= unpack_lo(ow[q]); sb -= unpack_hi(ow[q]); }
            }
        }
    }
    for (int it = (gw + NGW - (NPT % NGW)) % NGW; it < MS * 6; it += NGW) {
        const int row = MP + it / 6, ch = it % 6; const int rs = row - MP, b = rs / DSEQ, t = rs % DSEQ;
        if (ch < 4) {
            const int j = ch * 512 + lane * 8;
            const u32x4 w0 = *(const u32x4*)(U + (size_t)row * DM + j);
            f32x4 u0a = unpack_lo(w0), u0b = unpack_hi(w0), u1a, u1b, u2a, u2b;
            if (t >= 1) { const u32x4 w = *(const u32x4*)(U + (size_t)(row - 1) * DM + j); u1a = unpack_lo(w); u1b = unpack_hi(w); }
            else { const float* s = p.state_conv + ((size_t)b * 2 + 1) * DM + j; u1a = *(const f32x4*)s; u1b = *(const f32x4*)(s + 4); }
            if (t >= 2) { const u32x4 w = *(const u32x4*)(U + (size_t)(row - 2) * DM + j); u2a = unpack_lo(w); u2b = unpack_hi(w); }
            else { const float* s = p.state_conv + ((size_t)b * 2 + t) * DM + j; u2a = *(const f32x4*)s; u2b = *(const f32x4*)(s + 4); }
            const float* cw = p.conv_w + j;
            const f32x4 c0a = *(const f32x4*)cw, c0b = *(const f32x4*)(cw + 4), c1a = *(const f32x4*)(cw + DM), c1b = *(const f32x4*)(cw + DM + 4), c2a = *(const f32x4*)(cw + 2 * DM), c2b = *(const f32x4*)(cw + 2 * DM + 4);
            const u32x4 bw = *(const u32x4*)(Bb + (size_t)row * DM + j);
            const f32x4 ra = unpack_lo(bw) * (c0a * u2a + c1a * u1a + c2a * u0a), rb = unpack_hi(bw) * (c0b * u2b + c1b * u1b + c2b * u0b);
            if (st) *(u32x4*)(Bb + (size_t)row * DM + j) = pack8(ra, rb);
        } else {
            const int j = (ch - 4) * 512 + lane * 8, g = j >> 8, w = 2 << g;
            f32x4 sa = z4, sb = z4, va = z4, vb = z4;
            for (int k = 0; k < 16; ++k) {
                if (k < w) {
                    const int tt = t - k;
                    if (tt >= 0) { const u32x4 x = *(const u32x4*)(V + (size_t)(row - k) * DPOOL + j); const f32x4 a = unpack_lo(x), c = unpack_hi(x); sa += a; sb += c; if (k == 0) { va = a; vb = c; } }
                    else { const float* s = p.state_pool + ((size_t)b * 15 + (15 + tt)) * DPOOL + j; sa += *(const f32x4*)s; sb += *(const f32x4*)(s + 4); }
                }
            }
            const float inv = 1.0f / (float)w;
            if (st) *(u32x4*)(PO + (size_t)row * DPOOL + j) = pack8(sa * inv - va, sb * inv - vb);
        }
    }
    if (!st) return;
    float* o_cp = p.out + (size_t)MT * DM; float* o_pp = o_cp + NB * 2 * DM; float* o_cs = o_pp + NB * 15 * DPOOL; float* o_ps = o_cs + DBATCH * 2 * DM;
    const int tid = gw * 64 + lane, nth = NGW * 64;
    constexpr int N_CP = NB * 2 * DM / 8, N_PP = NB * 15 * DPOOL / 8, N_CS = DBATCH * 2 * DM / 8, N_PS = DBATCH * 15 * DPOOL / 8;
    for (int i = tid; i < N_CP + N_PP + N_CS + N_PS; i += nth) {
        int r = i; const bf16_t* src = nullptr; const float* fsrc = nullptr; float* dst;
        if (r < N_CP) { const int j8 = r % 256, ii = (r / 256) % 2, b = r / 512; src = U + (size_t)(b * SEQ + SEQ - 2 + ii) * DM + j8 * 8; dst = o_cp + (size_t)r * 8; }
        else if ((r -= N_CP) < N_PP) { const int j8 = r % 128, ii = (r / 128) % 15, b = r / 1920; src = V + (size_t)(b * SEQ + SEQ - 15 + ii) * DPOOL + j8 * 8; dst = o_pp + (size_t)r * 8; }
        else if ((r -= N_PP) < N_CS) { const int j8 = r % 256, ii = (r / 256) % 2, b = r / 512; src = U + (size_t)(MP + b * DSEQ + DSEQ - 2 + ii) * DM + j8 * 8; dst = o_cs + (size_t)r * 8; }
        else { r -= N_CS; const int j8 = r % 128, ii = (r / 128) % 15, b = r / 1920; dst = o_ps + (size_t)r * 8;
            if (ii <= 10) fsrc = p.state_pool + ((size_t)b * 15 + 4 + ii) * DPOOL + j8 * 8; else src = V + (size_t)(MP + b * DSEQ + ii - 11) * DPOOL + j8 * 8; }
        f32x4 a, c;
        if (fsrc) { a = *(const f32x4*)fsrc; c = *(const f32x4*)(fsrc + 4); } else { const u32x4 x = *(const u32x4*)src; a = unpack_lo(x); c = unpack_hi(x); }
        *(f32x4*)dst = a; *(f32x4*)(dst + 4) = c;
    }
}

__device__ __forceinline__ void phase8(const Params& p, const bool st) {
    FRESH_IDS;
    const float* ssq2 = (const float*)(p.ws + WS_CTL + 65536); const bf16_t* XB = (const bf16_t*)(p.ws + WS_SGC); const float* PART = (const float*)(p.ws + WS_WIN);
    for (int row = gw; row < MT; row += NGW) {
        f32x4* yr = (f32x4*)(p.out + (size_t)row * DM);
        const u32x4* xr = (const u32x4*)(XB + (size_t)row * DM);
        f32x4 v[8];
#pragma unroll
        for (int j = 0; j < 4; ++j) { const u32x4 x = __builtin_nontemporal_load(xr + 64 * j + lane); v[2 * j] = unpack_lo(x); v[2 * j + 1] = unpack_hi(x); }
        float rr;
        if (row < MP) rr = 1.0f / sqrtf(ssq2[row] * (1.0f / DM) + EPS);
        else {
            for (int sl = 0; sl < DFF / 512; ++sl) { const f32x4* pr = (const f32x4*)(PART + ((size_t)sl * MS + (row - MP)) * DM);
#pragma unroll
                for (int j = 0; j < 4; ++j) { const int e = (64 * j + lane) * 2; v[2 * j] += __builtin_nontemporal_load(pr + e); v[2 * j + 1] += __builtin_nontemporal_load(pr + e + 1); } }
            float s = 0.f;
#pragma unroll
            for (int j = 0; j < 8; ++j) s += dot4(v[j]);
            rr = 1.0f / sqrtf(wave_sum(s) * (1.0f / DM) + EPS);
        }
#pragma unroll
        for (int j = 0; j < 4; ++j) { const int e = (64 * j + lane) * 2; const f32x4 g0 = ((const f32x4*)p.norm_final)[e], g1 = ((const f32x4*)p.norm_final)[e + 1];
            const f32x4 o0 = v[2 * j] * rr * g0, o1 = v[2 * j + 1] * rr * g1; if (st) { __builtin_nontemporal_store(o0, yr + e); __builtin_nontemporal_store(o1, yr + e + 1); } }
    }
}

#define XB_TMO      128
#define XB_XCNT(j)  (256  + 64 * (j))
#define XB_XSUB(j)  (1280 + 64 * (j))
#define XB_XGEN(j)  (2304 + 64 * (j))
#define XB_TOP      3328
#define XB_TOPGEN   3392
#define XCD_BAR_WORDS 3456
#define XB_SPIN_CAP (1u << 18)
__device__ __forceinline__ unsigned xb_ld(unsigned* p)              { return __hip_atomic_load(p, __ATOMIC_RELAXED, __HIP_MEMORY_SCOPE_AGENT); }
__device__ __forceinline__ unsigned xb_add(unsigned* p, unsigned v) { return __hip_atomic_fetch_add(p, v, __ATOMIC_RELAXED, __HIP_MEMORY_SCOPE_AGENT); }
__device__ __forceinline__ unsigned xb_xcc_id() { return (unsigned)__builtin_amdgcn_s_getreg((3 << 11) | 20) & 0xFu; }
#define XB_SPIN(cond, bar) do { unsigned _sp = 0; while (cond) { __builtin_amdgcn_s_sleep(1); \
    if ((++_sp & 255u) == 0u) { if (xb_ld(&(bar)[XB_TMO])) break; if (_sp > XB_SPIN_CAP) { atomicAdd(&(bar)[XB_TMO], 1u); break; } } } } while (0)
struct XcdBarrier { unsigned* bar; unsigned x; volatile LAS unsigned* st; };
__device__ __forceinline__ XcdBarrier xcd_barrier_post(unsigned* bar, volatile LAS unsigned* st) {
    XcdBarrier b; b.bar = bar; b.x = xb_xcc_id(); b.st = st;
    if (threadIdx.x == 0) (void)xb_add(&bar[XB_XCNT(b.x)], 1u);
    return b;
}
__device__ __forceinline__ void xcd_barrier_complete(unsigned* bar, unsigned x, unsigned& nloc, unsigned& nx) {
    const unsigned G = gridDim.x * gridDim.y * gridDim.z;
    unsigned sum, cnt, mine, sp = 0u;
    for (;;) {
        sum = 0u; cnt = 0u; mine = 0u;
#pragma unroll
        for (unsigned j = 0; j < 16; ++j) { const unsigned c = xb_ld(&bar[XB_XCNT(j)]); sum += c; cnt += (c > 0u) ? 1u : 0u; mine = (j == x) ? c : mine; }
        if (sum == G) break;
        __builtin_amdgcn_s_sleep(1);
        if ((++sp & 255u) == 0u) { if (xb_ld(&bar[XB_TMO])) break; if (sp > XB_SPIN_CAP) { atomicAdd(&bar[XB_TMO], 1u); break; } }
    }
    nloc = mine > 0u ? mine : 1u; nx = cnt > 0u ? cnt : 1u;
}
__device__ __forceinline__ void xcd_barrier(const XcdBarrier& b) {
    asm volatile("s_waitcnt vmcnt(0)" ::: "memory");
    __syncthreads();
    if (threadIdx.x == 0) {
        unsigned* bar = b.bar;
        __builtin_amdgcn_s_waitcnt(0);
        unsigned nloc = b.st[0], nx = b.st[1];
        if (nloc == 0u) { xcd_barrier_complete(bar, b.x, nloc, nx); b.st[0] = nloc; b.st[1] = nx; }
        const unsigned old = xb_add(&bar[XB_XSUB(b.x)], 1u);
        const unsigned gen = old / nloc;
        if (old + 1u == (gen + 1u) * nloc) {
            __builtin_amdgcn_fence(__ATOMIC_RELEASE, "agent");
            asm volatile("s_waitcnt vmcnt(0)" ::: "memory");
            const unsigned og = xb_add(&bar[XB_TOP], 1u);
            const unsigned tg = og / nx;
            if (og + 1u == (tg + 1u) * nx) xb_add(&bar[XB_TOPGEN], 1u);
            else XB_SPIN(xb_ld(&bar[XB_TOPGEN]) == tg, bar);
            __builtin_amdgcn_fence(__ATOMIC_ACQUIRE, "agent");
            xb_add(&bar[XB_XGEN(b.x)], 1u);
            asm volatile("s_waitcnt vmcnt(0)" ::: "memory");
        } else {
            XB_SPIN(xb_ld(&bar[XB_XGEN(b.x)]) == gen, bar);
            __builtin_amdgcn_fence(__ATOMIC_ACQUIRE, "agent");
            asm volatile("s_waitcnt vmcnt(0)" ::: "memory");
        }
    }
    __syncthreads();
}

__global__ void __launch_bounds__(NWAVES * 64, 2) fwd_mega(Params p) {
    extern __shared__ __attribute__((aligned(16))) unsigned char lds_raw[];
    LAS unsigned char* lds = (LAS unsigned char*)lds_raw;
    cg::grid_group grid = cg::this_grid();
    const int G = gridDim.x, bx = blockIdx.x;
    unsigned char* ws = p.ws;
    if (ws == nullptr) grid.sync();
    volatile LAS unsigned* bst = (volatile LAS unsigned*)(lds + RING_BYTES + 64);
    if (threadIdx.x < 2) bst[threadIdx.x] = 0u;
    __syncthreads();
    const XcdBarrier bar = xcd_barrier_post((unsigned*)(ws + WS_BAR), bst);
#define GRID_SYNC() xcd_barrier(bar)
    float* ssq1 = (float*)(ws + WS_CTL); float* ssq2 = (float*)(ws + WS_CTL + 65536);

    for (int rep = 0; rep < REP0; ++rep) { phase0(p, lds); __syncthreads(); }
    for (int rep = 0; rep < REPS; ++rep) GRID_SYNC();
    {
        pg8::Gemm g{(const bf16_t*)(ws + WS_XN), (const bf16_t*)(ws + WS_WIN), DM, DM, DM, 0}; pg8::StaticOrder S; S.init(MT, DIN, G, bx);
        EpiG1 E{(bf16_t*)(ws + WS_U), (bf16_t*)(ws + WS_B)};
        for (int rep = 0; rep < REP1; ++rep) pg8::gemm_phase(lds, g, S, E);
    }
    GRID_SYNC();
    for (int rep = 1; rep < REP2; ++rep) phase2(p, ws == nullptr);
    phase2(p, true);
    GRID_SYNC();
    {
        pg8::Gemm g{(const bf16_t*)(ws + WS_PO), (const bf16_t*)(ws + WS_WPL), DPOOL, 256, 256, 256}; pg8::StaticOrder S; S.init(MT, DPOOL, G, bx);
        EpiPool E{(bf16_t*)(ws + WS_XN), p.pool_scale};
        for (int rep = 0; rep < REP3; ++rep) pg8::gemm_phase(lds, g, S, E);
    }
    GRID_SYNC();
    {
        pg8::StaticOrder S; S.init(MP, DM, G, bx);
        { pg8::Gemm g{(const bf16_t*)(ws + WS_B), (const bf16_t*)(ws + WS_WBC), DM, DM, DM, 0}; EpiMerge<false> E{(const bf16_t*)(ws + WS_SGC), (bf16_t*)(ws + WS_U)}; pg8::gemm_phase(lds, g, S, E); }
        { pg8::Gemm g{(const bf16_t*)(ws + WS_XN), (const bf16_t*)(ws + WS_WBP), DPOOL, DPOOL, DPOOL, 0}; EpiMerge<true> E{(const bf16_t*)(ws + WS_SGP), (bf16_t*)(ws + WS_U)}; pg8::gemm_phase(lds, g, S, E); }
        for (int u = bx; u < (MS / 64) * (DM / 64); u += G) {
            const int row0 = MP + 64 * (u >> 5), col0 = 64 * (u & 31);
            f32x4 ya0, ya1, yb0, yb1;
            mini_gemm(lds, (const bf16_t*)(ws + WS_B), DM, (const bf16_t*)(ws + WS_WBC), DM, DM, row0, col0, ya0, ya1);
            mini_gemm(lds, (const bf16_t*)(ws + WS_XN), DPOOL, (const bf16_t*)(ws + WS_WBP), DPOOL, DPOOL, row0, col0, yb0, yb1);
            const size_t off = (size_t)(row0 + (threadIdx.x >> 3)) * DM + col0 + (threadIdx.x & 7) * 8;
            const u32x4 gc = *(const u32x4*)((const bf16_t*)(ws + WS_SGC) + off), gp = *(const u32x4*)((const bf16_t*)(ws + WS_SGP) + off);
            *(u32x4*)((bf16_t*)(ws + WS_U) + off) = pack8(unpack_lo(gc) * ya0 + unpack_lo(gp) * yb0, unpack_hi(gc) * ya1 + unpack_hi(gp) * yb1);
        }
    }
    GRID_SYNC();
    {
        pg8::Gemm g{(const bf16_t*)(ws + WS_U), (const bf16_t*)(ws + WS_WO), DM, DM, DM, 0}; pg8::StaticOrder S; S.init(MP, DM, G, bx);
        EpiRes<true> E{p.x_prompt, p.x_sample, p.norm_ffn, (bf16_t*)(ws + WS_SGC), (bf16_t*)(ws + WS_XN), ssq1};
        pg8::gemm_phase(lds, g, S, E);
        for (int u = bx; u < (MS / 64) * (DM / 64); u += G) {
            const int row0 = MP + 64 * (u >> 5), col0 = 64 * (u & 31);
            f32x4 y0, y1;
            mini_gemm(lds, (const bf16_t*)(ws + WS_U), DM, (const bf16_t*)(ws + WS_WO), DM, DM, row0, col0, y0, y1);
            const int row = row0 + (threadIdx.x >> 3), col = col0 + (threadIdx.x & 7) * 8; const size_t off = (size_t)row * DM + col;
            const float* xr = p.x_sample + (size_t)(row - MP) * DM + col;
            const f32x4 a0 = *(const f32x4*)xr + y0, a1 = *(const f32x4*)(xr + 4) + y1;
            *(u32x4*)((bf16_t*)(ws + WS_SGC) + off) = pack8(a0, a1);
            const f32x4 g0 = *(const f32x4*)(p.norm_ffn + col), g1 = *(const f32x4*)(p.norm_ffn + col + 4);
            *(u32x4*)((bf16_t*)(ws + WS_XN) + off) = pack8(a0 * g0, a1 * g1);
            float sq = dot4(a0) + dot4(a1); sq += __shfl_xor(sq, 1); sq += __shfl_xor(sq, 2); sq += __shfl_xor(sq, 4);
            if ((threadIdx.x & 7) == 0) atomicAdd(ssq1 + row, sq);
        }
    }
    GRID_SYNC();
    {
        pg8::Gemm g{(const bf16_t*)(ws + WS_XN), (const bf16_t*)(ws + WS_WGU), DM, DM, DM, 0}; pg8::StaticOrder S; S.init(MT, DIN, G, bx);
        EpiFF E{(bf16_t*)(ws + WS_FF), ssq1};
        for (int rep = 0; rep < REP6; ++rep) pg8::gemm_phase(lds, g, S, E);
    }
    GRID_SYNC();
    {
        { pg8::Gemm g{(const bf16_t*)(ws + WS_FF), (const bf16_t*)(ws + WS_WDN), DFF, DFF, DFF, 0}; pg8::StaticOrder S; S.init(MP, DM, G, bx);
          EpiRes<false> E{nullptr, nullptr, nullptr, (bf16_t*)(ws + WS_SGC), nullptr, ssq2};
          pg8::gemm_phase(lds, g, S, E); }
        { pg8::Gemm g{(const bf16_t*)(ws + WS_FF), (const bf16_t*)(ws + WS_WDN), DFF, DFF, 512, 0}; pg8::SplitKOrder S{G, bx, DFF / 512, MP / BM, 1024u};
          EpiPart E{(float*)(ws + WS_WIN), 1024u};
          pg8::gemm_phase(lds, g, S, E); }
    }
    GRID_SYNC();
    for (int rep = 1; rep < REP8; ++rep) phase8(p, ws == nullptr);
    phase8(p, true);
}

extern "C" void kernel_launch(void* const* d_in, const int* in_sizes, int n_in, void* d_out, int out_size, void* d_ws, size_t ws_size, hipStream_t stream) {
    static int grid = 0;
    if (grid == 0) {
        if (n_in != 17 || ws_size < WS_END) { fprintf(stderr, "kernel_launch: unexpected n_in %d or ws_size %zu (< %zu)\n", n_in, ws_size, (size_t)WS_END); grid = -1; return; }
        int dev = 0, cus = 0, per_cu = 0;
        if (hipGetDevice(&dev) != hipSuccess || hipDeviceGetAttribute(&cus, hipDeviceAttributeMultiprocessorCount, dev) != hipSuccess) { grid = -1; return; }
        if (hipFuncSetAttribute((const void*)fwd_mega, hipFuncAttributeMaxDynamicSharedMemorySize, LDS_BYTES) != hipSuccess) { fprintf(stderr, "kernel_launch: hipFuncSetAttribute failed\n"); grid = -1; return; }
        if (hipOccupancyMaxActiveBlocksPerMultiprocessor(&per_cu, (const void*)fwd_mega, NWAVES * 64, LDS_BYTES) != hipSuccess || per_cu < 1) { fprintf(stderr, "kernel_launch: occupancy query says %d\n", per_cu); per_cu = 1; }
        (void)hipGetLastError();
        grid = cus * per_cu;
    }
    if (grid < 0) return;
    if (hipMemsetAsync((char*)d_ws + WS_CTL, 0, CTL_ZERO_BYTES, stream) != hipSuccess) { fprintf(stderr, "kernel_launch: memset failed\n"); return; }
    Params p{};
    p.x_prompt = (const float*)d_in[0]; p.x_sample = (const float*)d_in[1]; p.state_conv = (const float*)d_in[2]; p.state_pool = (const float*)d_in[3];
    p.norm_mix = (const float*)d_in[4]; p.w_in = (const float*)d_in[5]; p.conv_w = (const float*)d_in[6]; p.w_pool = (const float*)d_in[7];
    p.pool_scale = (const float*)d_in[8]; p.w_br_conv = (const float*)d_in[9]; p.w_br_pool = (const float*)d_in[10]; p.w_o = (const float*)d_in[11];
    p.norm_ffn = (const float*)d_in[12]; p.w_gate = (const float*)d_in[13]; p.w_up = (const float*)d_in[14]; p.w_down = (const float*)d_in[15];
    p.norm_final = (const float*)d_in[16]; p.out = (float*)d_out; p.ws = (unsigned char*)d_ws;
    void* args[] = {&p};
    hipError_t e = hipLaunchCooperativeKernel((const void*)fwd_mega, dim3(grid), dim3(NWAVES * 64), args, LDS_BYTES, stream);
    if (e != hipSuccess) fprintf(stderr, "kernel_launch: cooperative launch failed: %s (grid %d)\n", hipGetErrorString(e), grid);
}
```

```cpp
#include <hip/hip_runtime.h>
#include <hip/hip_cooperative_groups.h>
#include <cstdio>
#include <cstdint>
namespace cg = cooperative_groups;

#define LAS __attribute__((address_space(3)))
typedef unsigned short bf16_t;
typedef short bf16x8 __attribute__((ext_vector_type(8)));
typedef float f32x4 __attribute__((ext_vector_type(4)));
typedef unsigned u32x4 __attribute__((ext_vector_type(4)));
typedef unsigned u32x2 __attribute__((ext_vector_type(2)));

constexpr int DM = 2048, MP = 8192, MS = 512, MT = MP + MS, SEQ = 2048, DSEQ = 4, DBATCH = 128, NB = 4;
constexpr int DIN = 11264, DPOOL = 1024, DFF = 5632;
constexpr int C_H = 0, C_B = 2048, C_C = 4096, C_V = 6144, C_GC = 7168, C_GP = 9216;
constexpr float EPS = 1e-6f;
constexpr int NWAVES = 8;
#ifndef REP0
#define REP0 1
#endif
#ifndef REP1
#define REP1 1
#endif
#ifndef REP3
#define REP3 1
#endif
#ifndef REP4
#define REP4 1
#endif
#ifndef REP6
#define REP6 1
#endif
#ifndef REP2
#define REP2 1
#endif
#ifndef REP5
#define REP5 1
#endif
#ifndef REP7
#define REP7 1
#endif
#ifndef REP8
#define REP8 1
#endif
#ifndef REPS
#define REPS 1
#endif

constexpr size_t MiB = 1u << 20;
constexpr size_t WS_CTL = 0;
constexpr size_t WS_BAR = 256 * 1024, CTL_ZERO_BYTES = 512 * 1024;
constexpr size_t WS_WIN = 1 * MiB;
constexpr size_t WS_WGU = 45 * MiB;
constexpr size_t WS_WDN = 89 * MiB;
constexpr size_t WS_WBC = 111 * MiB;
constexpr size_t WS_WO = 119 * MiB;
constexpr size_t WS_WBP = 127 * MiB;
constexpr size_t WS_WPL = 131 * MiB;
constexpr size_t WS_XN = 132 * MiB;
constexpr size_t WS_U = 166 * MiB;
constexpr size_t WS_B = 200 * MiB;
constexpr size_t WS_V = 234 * MiB;
constexpr size_t WS_PO = 251 * MiB;
constexpr size_t WS_SGC = 268 * MiB;
constexpr size_t WS_SGP = 302 * MiB;
constexpr size_t WS_END = 336 * MiB;
constexpr size_t WS_FF = WS_U;
static_assert(WS_FF + (size_t)MT * DFF * 2 <= WS_SGC, "FF overlay");
static_assert(WS_V == WS_B + 34 * MiB && WS_SGC == WS_B + 68 * MiB && WS_SGP == WS_B + 102 * MiB, "EpiG1 region arithmetic");

constexpr int RING_BYTES = 131072, LDS_BYTES = 147456;

__device__ __forceinline__ unsigned cvt_pk_bf16(float lo, float hi) { unsigned r; asm volatile("v_cvt_pk_bf16_f32 %0, %1, %2" : "=v"(r) : "v"(lo), "v"(hi)); return r; }
__device__ __forceinline__ u32x4 pack8(f32x4 a, f32x4 b) { u32x4 w; w.x = cvt_pk_bf16(a[0], a[1]); w.y = cvt_pk_bf16(a[2], a[3]); w.z = cvt_pk_bf16(b[0], b[1]); w.w = cvt_pk_bf16(b[2], b[3]); return w; }
__device__ __forceinline__ f32x4 unpack_lo(u32x4 w) { return (f32x4){__uint_as_float(w.x << 16), __uint_as_float(w.x & 0xffff0000u), __uint_as_float(w.y << 16), __uint_as_float(w.y & 0xffff0000u)}; }
__device__ __forceinline__ f32x4 unpack_hi(u32x4 w) { return (f32x4){__uint_as_float(w.z << 16), __uint_as_float(w.z & 0xffff0000u), __uint_as_float(w.w << 16), __uint_as_float(w.w & 0xffff0000u)}; }
__device__ __forceinline__ float bf2f(bf16_t b) { return __uint_as_float(((unsigned)b) << 16); }
__device__ __forceinline__ float sigm(float x) { return __builtin_amdgcn_rcpf(1.0f + __builtin_amdgcn_exp2f(-1.44269504f * x)); }
__device__ __forceinline__ f32x4 exp2_4(f32x4 t) { return (f32x4){__builtin_amdgcn_exp2f(t[0]), __builtin_amdgcn_exp2f(t[1]), __builtin_amdgcn_exp2f(t[2]), __builtin_amdgcn_exp2f(t[3])}; }
__device__ __forceinline__ f32x4 rcp4(f32x4 d) { return (f32x4){__builtin_amdgcn_rcpf(d[0]), __builtin_amdgcn_rcpf(d[1]), __builtin_amdgcn_rcpf(d[2]), __builtin_amdgcn_rcpf(d[3])}; }
__device__ __forceinline__ f32x4 sigm4(f32x4 v) { return rcp4(exp2_4(v * -1.44269504f) + 1.0f); }
__device__ __forceinline__ float dot4(f32x4 v) { return (v[0] * v[0] + v[1] * v[1]) + (v[2] * v[2] + v[3] * v[3]); }

namespace pg8 {
constexpr int BM = 256, BK = 64, HALF = 128, HTB = HALF * BK * 2, STAGE_BYTES = 8 * HTB, NXCD = 8, WGM = 8;
__host__ __device__ __forceinline__ int lds_byte(int r, int c) { const int st = (r >> 4) * 2 + (c >> 5), rr = r & 15, cc = c & 31, ob = rr * 64 + cc * 2; return st * 1024 + (ob ^ (((ob >> 9) & 1) << 5)); }
__host__ __device__ __forceinline__ void stage_rc(int b, int& R, int& C) { const int st = b / 1024, sb = b % 1024, swz = sb ^ (((sb >> 9) & 1) << 5); R = (st >> 1) * 16 + swz / 64; C = (st & 1) * 32 + (swz % 64) / 2; }
__host__ __device__ __forceinline__ int perm32(int rho) { const int n = rho >> 4, i = rho & 15; return 8 * (i >> 2) + 4 * n + (i & 3); }

struct Unit { int pm, pn; unsigned kofs; };
struct Gemm { const bf16_t* A; const bf16_t* Bt; int lda, ldb, K, a_koff; };

struct StaticOrder {
    int nM, nN, nwg, G, c;
    __host__ __device__ void init(int M, int N, int G_, int c_) { nM = M / BM; nN = N / BM; nwg = nM * nN; G = G_; c = c_; }
    __host__ __device__ bool next(int i, Unit& u) const {
        const long L = (long)i * G + c; if (L >= nwg) return false;
        int wgid = (int)L; { const int q = nwg / NXCD, r = nwg % NXCD, xcd = wgid % NXCD, off = wgid / NXCD; wgid = (xcd < r ? xcd * (q + 1) : r * (q + 1) + (xcd - r) * q) + off; }
        const int nig = WGM * nN, gid = wgid / nig, fm = gid * WGM, gsz = (nM - fm) < WGM ? (nM - fm) : WGM;
        u.pm = fm + ((wgid % nig) % gsz); u.pn = (wgid % nig) / gsz; u.kofs = 0u; return true;
    }
    __device__ __forceinline__ void a_ready(const Unit&) const {}
    __device__ __forceinline__ void done(const Unit&) const {}
};

struct SplitKOrder {
    int G, c, nsl, pm0; unsigned slice_bytes;
    __device__ __forceinline__ bool next(int i, Unit& u) const { const int L = i * G + c; if (L >= 16 * nsl) return false; const int sl = L >> 4, q = L & 15; u.pm = pm0 + (q >> 3); u.pn = q & 7; u.kofs = (unsigned)sl * slice_bytes; return true; }
    __device__ __forceinline__ void a_ready(const Unit&) const {}
    __device__ __forceinline__ void done(const Unit&) const {}
};
template <class Epi, class Sched>
__device__ __forceinline__ void gemm_phase(LAS unsigned char* lds, const Gemm g, const Sched& S, const Epi& E) {
    int tid = threadIdx.x; asm volatile("" : "+v"(tid));
    const int wid = __builtin_amdgcn_readfirstlane(tid >> 6), lane = tid & 63, wr = wid >> 2, wc = wid & 3, fr = lane & 15, fq = lane >> 4;
    const int K = g.K, nt = K / BK;
    unsigned voffA, voffB;
    { int R, C; stage_rc(tid * 16, R, C); const int Rb = (R & ~31) + perm32(R & 31); voffA = (unsigned)(R * g.lda + C) * 2u; voffB = (unsigned)(Rb * g.ldb + C) * 2u; }
    const size_t kstep = (size_t)(BK * 2);
    const size_t hstepA = (size_t)HALF * g.lda * 2, hstepB = (size_t)HALF * g.ldb * 2;
    const size_t tstepA = 2 * hstepA, tstepB = 2 * hstepB, qstepA = hstepA / 2, qstepB = hstepB / 2;
    struct voffA_tag_t { char c; }; struct voffB_tag_t { char c[2]; }; typedef voffA_tag_t voffA_tag; typedef voffB_tag_t voffB_tag;
    const unsigned ldsw = (unsigned)wid * 1024u;
    const int aoff = lds_byte(wr * 64 + fr, fq * 8), boff = lds_byte(wc * 32 + fr, fq * 8);
#define PG8_SA(b, h) (((b) * 2 + (h)) * HTB)
#define PG8_SB(b, h) ((4 + (b) * 2 + (h)) * HTB)
#define PG8_STAGE(bufoff, gbase, voff) do { _Pragma("unroll") for (int _i = 0; _i < 2; ++_i) \
        __builtin_amdgcn_global_load_lds((const unsigned*)((const char*)(gbase) + (size_t)_i * (sizeof(voff##_tag) == 1 ? qstepA : qstepB) + (voff)), (LAS unsigned*)(lds + (bufoff) + ldsw + _i * 8192), 16, 0, 0); } while (0)
#define PG8_LDA(dst, b, h) do { _Pragma("unroll") for (int m = 0; m < 4; ++m) _Pragma("unroll") for (int k = 0; k < 2; ++k) dst[m][k] = *(const LAS bf16x8*)(lds + PG8_SA(b, h) + aoff + m * 2048 + k * 1024); } while (0)
#define PG8_LDB(dst, b, h) do { _Pragma("unroll") for (int n = 0; n < 2; ++n) _Pragma("unroll") for (int k = 0; k < 2; ++k) dst[n][k] = *(const LAS bf16x8*)(lds + PG8_SB(b, h) + boff + n * 2048 + k * 1024); } while (0)
#define PG8_MMA(ai, bj, At, Bt) do { __builtin_amdgcn_s_setprio(1); _Pragma("unroll") for (int m = 0; m < 4; ++m) _Pragma("unroll") for (int n = 0; n < 2; ++n) _Pragma("unroll") for (int k = 0; k < 2; ++k) \
        acc[ai][bj][m][n] = __builtin_amdgcn_mfma_f32_16x16x32_bf16(Bt[n][k], At[m][k], acc[ai][bj][m][n], 0, 0, 0); __builtin_amdgcn_s_setprio(0); } while (0)
#define PG8_WAIT_V(n) asm volatile("s_waitcnt vmcnt(" #n ")" ::: "memory")
#define PG8_WAIT_L(n) asm volatile("s_waitcnt lgkmcnt(" #n ")" ::: "memory")
#define PG8_BAR __builtin_amdgcn_s_barrier()
#define PG8_SCHED __builtin_amdgcn_sched_barrier(0)
    Unit cur, nxt; int ui = 0;
    if (!S.next(0, cur)) return;
    f32x4 acc[2][2][4][2];
#pragma unroll
    for (int a = 0; a < 2; ++a)
#pragma unroll
        for (int b = 0; b < 2; ++b)
#pragma unroll
            for (int m = 0; m < 4; ++m)
#pragma unroll
                for (int n = 0; n < 2; ++n) acc[a][b][m][n] = (f32x4){0.f, 0.f, 0.f, 0.f};
    bf16x8 At[4][2], B0[2][2], B1[2][2];
    const char* cA = (const char*)g.A + (size_t)cur.pm * tstepA + (size_t)cur.pn * g.a_koff * 2 + cur.kofs; const char* cB = (const char*)g.Bt + (size_t)cur.pn * tstepB + cur.kofs;
    S.a_ready(cur);
    PG8_STAGE(PG8_SB(0, 0), cB, voffB); PG8_STAGE(PG8_SB(0, 1), cB + hstepB, voffB); PG8_STAGE(PG8_SA(0, 0), cA, voffA); PG8_STAGE(PG8_SA(0, 1), cA + hstepA, voffA);
    if (wr == 1) PG8_BAR;
    PG8_WAIT_V(2); PG8_BAR;
    PG8_STAGE(PG8_SB(1, 0), cB + kstep, voffB); PG8_STAGE(PG8_SA(1, 0), cA + kstep, voffA); PG8_STAGE(PG8_SB(1, 1), cB + hstepB + kstep, voffB);
    PG8_WAIT_V(6); PG8_BAR;
    for (;;) {
        const bool has_next = S.next(ui + 1, nxt);
        const char* nA = has_next ? (const char*)g.A + (size_t)nxt.pm * tstepA + (size_t)nxt.pn * g.a_koff * 2 + nxt.kofs : cA; const char* nB = has_next ? (const char*)g.Bt + (size_t)nxt.pn * tstepB + nxt.kofs : cB;
        for (int t = 0; t < nt; t += 2) {
            const bool last = (t == nt - 2);
            const char* a1 = cA + (size_t)(t + 1) * kstep;
            const char* a2 = last ? nA : cA + (size_t)(t + 2) * kstep; const char* b2 = last ? nB : cB + (size_t)(t + 2) * kstep;
            const char* a3 = a2 + kstep; const char* b3 = b2 + kstep;
            if (last && has_next) S.a_ready(nxt);
            PG8_LDB(B0, 0, 0); PG8_LDB(B1, 0, 1); PG8_SCHED; PG8_LDA(At, 0, 0); PG8_STAGE(PG8_SA(1, 1), a1 + hstepA, voffA);
            PG8_WAIT_V(8); PG8_WAIT_L(0); PG8_BAR; PG8_MMA(0, 0, At, B0); PG8_MMA(0, 1, At, B1); PG8_BAR; PG8_SCHED;
            PG8_LDA(At, 0, 1); PG8_STAGE(PG8_SB(0, 0), b2, voffB); PG8_STAGE(PG8_SB(0, 1), b2 + hstepB, voffB); PG8_STAGE(PG8_SA(0, 0), a2, voffA);
            PG8_WAIT_V(8); PG8_WAIT_L(0); PG8_BAR; PG8_MMA(1, 0, At, B0); PG8_MMA(1, 1, At, B1); PG8_BAR; PG8_SCHED;
            PG8_LDB(B0, 1, 0); PG8_LDB(B1, 1, 1); PG8_SCHED; PG8_LDA(At, 1, 0); PG8_STAGE(PG8_SA(0, 1), a2 + hstepA, voffA);
            PG8_WAIT_V(8); PG8_WAIT_L(0); PG8_BAR; PG8_MMA(0, 0, At, B0); PG8_MMA(0, 1, At, B1); PG8_BAR; PG8_SCHED;
            PG8_LDA(At, 1, 1); PG8_STAGE(PG8_SB(1, 0), b3, voffB); PG8_STAGE(PG8_SB(1, 1), b3 + hstepB, voffB); PG8_STAGE(PG8_SA(1, 0), a3, voffA);
            PG8_WAIT_V(8); PG8_WAIT_L(0); PG8_BAR; PG8_MMA(1, 0, At, B0); PG8_MMA(1, 1, At, B1); PG8_BAR; PG8_SCHED;
        }
        if (wr == 0) PG8_BAR;
        E(acc, cur, wr, wc, fr, fq); S.done(cur);
        if (!has_next) break;
#pragma unroll
        for (int a = 0; a < 2; ++a)
#pragma unroll
            for (int b = 0; b < 2; ++b)
#pragma unroll
                for (int m = 0; m < 4; ++m)
#pragma unroll
                    for (int n = 0; n < 2; ++n) acc[a][b][m][n] = (f32x4){0.f, 0.f, 0.f, 0.f};
        cur = nxt; cA = nA; cB = nB; ++ui;
        if (wr == 1) PG8_BAR;
    }
    PG8_WAIT_V(0);
    PG8_BAR;
#undef PG8_SA
#undef PG8_SB
#undef PG8_STAGE
#undef PG8_LDA
#undef PG8_LDB
#undef PG8_MMA
#undef PG8_WAIT_V
#undef PG8_WAIT_L
#undef PG8_BAR
#undef PG8_SCHED
}
}
using pg8::Unit; using pg8::BM; using pg8::HALF;

typedef const f32x4 (&AccRef)[2][2][4][2];
struct EpiG1 {
    bf16_t *U, *Bb;
    __device__ __forceinline__ void operator()(AccRef acc, const Unit& u, int wr, int wc, int fr, int fq) const {
        const int row0 = u.pm * BM + wr * 64 + fr, cw = wc * 32 + 8 * fq;
        if (u.pn < 16) {
#pragma unroll
            for (int ai = 0; ai < 2; ++ai)
#pragma unroll
                for (int m = 0; m < 4; ++m) { bf16_t* rowp = U + (size_t)(row0 + ai * HALF + m * 16) * DM + u.pn * 128 + cw;
                    *(u32x4*)rowp = pack8(acc[ai][0][m][0] * acc[ai][1][m][0], acc[ai][0][m][1] * acc[ai][1][m][1]); }
        } else {
            const int g24 = u.pn >= 24, g28 = u.pn >= 28, g36 = u.pn >= 36, ridx = g24 + g28 + g36;
            bf16_t* base = (bf16_t*)((unsigned char*)Bb + (size_t)ridx * (34 * MiB));
            const int ldc = (ridx == 1) ? DPOOL : DM, colt = (u.pn - (16 + 8 * g24 + 4 * g28 + 8 * g36)) * 256; const bool sg = ridx >= 2;
#pragma unroll
            for (int ai = 0; ai < 2; ++ai)
#pragma unroll
                for (int m = 0; m < 4; ++m) { bf16_t* rowp = base + (size_t)(row0 + ai * HALF + m * 16) * ldc + colt + cw;
#pragma unroll
                    for (int bj = 0; bj < 2; ++bj) { f32x4 v0 = acc[ai][bj][m][0], v1 = acc[ai][bj][m][1];
                        if (sg) { v0 = sigm4(v0); v1 = sigm4(v1); }
                        *(u32x4*)(rowp + bj * HALF) = pack8(v0, v1); } }
        }
    }
};
struct EpiPool {
    bf16_t* MX; const float* ps;
    __device__ __forceinline__ void operator()(AccRef acc, const Unit& u, int wr, int wc, int fr, int fq) const {
        const int row0 = u.pm * BM + wr * 64 + fr, c0 = u.pn * 256 + wc * 32 + 8 * fq;
        f32x4 s[2][2];
#pragma unroll
        for (int bj = 0; bj < 2; ++bj) { s[bj][0] = *(const f32x4*)(ps + c0 + bj * HALF); s[bj][1] = *(const f32x4*)(ps + c0 + bj * HALF + 4); }
#pragma unroll
        for (int ai = 0; ai < 2; ++ai)
#pragma unroll
            for (int m = 0; m < 4; ++m) { bf16_t* rowp = MX + (size_t)(row0 + ai * HALF + m * 16) * DPOOL + c0;
#pragma unroll
                for (int bj = 0; bj < 2; ++bj) *(u32x4*)(rowp + bj * HALF) = pack8(acc[ai][bj][m][0] * s[bj][0], acc[ai][bj][m][1] * s[bj][1]); }
    }
};
template <bool SECOND> struct EpiMerge {
    const bf16_t* SG; bf16_t* MG;
    __device__ __forceinline__ void operator()(AccRef acc, const Unit& u, int wr, int wc, int fr, int fq) const {
        const int row0 = u.pm * BM + wr * 64 + fr, c0 = u.pn * 256 + wc * 32 + 8 * fq;
#pragma unroll
        for (int ai = 0; ai < 2; ++ai)
#pragma unroll
            for (int m = 0; m < 4; ++m) { const size_t off = (size_t)(row0 + ai * HALF + m * 16) * DM + c0;
#pragma unroll
                for (int bj = 0; bj < 2; ++bj) { const u32x4 g = *(const u32x4*)(SG + off + bj * HALF);
                    f32x4 v0 = unpack_lo(g) * acc[ai][bj][m][0], v1 = unpack_hi(g) * acc[ai][bj][m][1];
                    if (SECOND) { const u32x4 o = *(const u32x4*)(MG + off + bj * HALF); v0 += unpack_lo(o); v1 += unpack_hi(o); }
                    *(u32x4*)(MG + off + bj * HALF) = pack8(v0, v1); }
                asm volatile("" ::: "memory"); }
    }
};
template <bool FIRST> struct EpiRes {
    const float* xp; const float* xs; const float* gf; bf16_t* XB; bf16_t* XG; float* ssq;
    __device__ __forceinline__ void operator()(AccRef acc, const Unit& u, int wr, int wc, int fr, int fq) const {
        const int row0 = u.pm * BM + wr * 64 + fr, c0 = u.pn * 256 + wc * 32 + 8 * fq;
        const float* xbase = (u.pm < MP / BM) ? xp : xs - (size_t)MP * DM;
#pragma unroll
        for (int ai = 0; ai < 2; ++ai)
#pragma unroll
            for (int m = 0; m < 4; ++m) { const int row = row0 + ai * HALF + m * 16; const size_t off = (size_t)row * DM + c0; float s = 0.f;
#pragma unroll
                for (int bj = 0; bj < 2; ++bj) { f32x4 xa, xb;
                    if (FIRST) { xa = __builtin_nontemporal_load((const f32x4*)(xbase + off + bj * HALF)); xb = __builtin_nontemporal_load((const f32x4*)(xbase + off + bj * HALF + 4)); }
                    else { const u32x4 w = *(const u32x4*)(XB + off + bj * HALF); xa = unpack_lo(w); xb = unpack_hi(w); }
                    const f32x4 v0 = xa + acc[ai][bj][m][0], v1 = xb + acc[ai][bj][m][1];
                    *(u32x4*)(XB + off + bj * HALF) = pack8(v0, v1);
                    s += dot4(v0) + dot4(v1);
                    if (FIRST) { const f32x4 g0 = *(const f32x4*)(gf + c0 + bj * HALF), g1 = *(const f32x4*)(gf + c0 + bj * HALF + 4);
                        *(u32x4*)(XG + off + bj * HALF) = pack8(v0 * g0, v1 * g1); } }
                s += __shfl_xor(s, 16); s += __shfl_xor(s, 32);
                if (fq == 0) atomicAdd(ssq + row, s);
                asm volatile("" ::: "memory"); }
    }
};
struct EpiPart {
    float* PART; unsigned slice_bytes;
    __device__ __forceinline__ void operator()(AccRef acc, const Unit& u, int wr, int wc, int fr, int fq) const {
        const int row0 = (u.pm - MP / BM) * BM + wr * 64 + fr, c0 = u.pn * 256 + wc * 32 + 8 * fq;
        float* base = PART + (size_t)(u.kofs / slice_bytes) * MS * DM;
#pragma unroll
        for (int ai = 0; ai < 2; ++ai)
#pragma unroll
            for (int m = 0; m < 4; ++m) { float* rp = base + (size_t)(row0 + ai * HALF + m * 16) * DM + c0;
#pragma unroll
                for (int bj = 0; bj < 2; ++bj) { *(f32x4*)(rp + bj * HALF) = acc[ai][bj][m][0]; *(f32x4*)(rp + bj * HALF + 4) = acc[ai][bj][m][1]; } }
    }
};
struct EpiFF {
    bf16_t* FF; const float* ssq;
    __device__ __forceinline__ void operator()(AccRef acc, const Unit& u, int wr, int wc, int fr, int fq) const {
        const int row0 = u.pm * BM + wr * 64 + fr, c0 = u.pn * 128 + wc * 32 + 8 * fq;
#pragma unroll
        for (int ai = 0; ai < 2; ++ai)
#pragma unroll
            for (int m = 0; m < 4; ++m) { const int row = row0 + ai * HALF + m * 16;
                const float r = __builtin_amdgcn_rsqf(ssq[row] * (1.0f / DM) + EPS), kr = -1.44269504f * r, r2 = r * r;
                f32x4 o[2];
#pragma unroll
                for (int n = 0; n < 2; ++n) { const f32x4 a = acc[ai][0][m][n], b = acc[ai][1][m][n]; o[n] = (a * b) * (rcp4(exp2_4(a * kr) + 1.0f) * r2); }
                *(u32x4*)(FF + (size_t)row * DFF + c0) = pack8(o[0], o[1]); }
    }
};


__device__ __forceinline__ void mini_gemm(LAS unsigned char* lds, const bf16_t* A, int lda, const bf16_t* Bt, int ldb, int K, int row0, int col0, f32x4& v0, f32x4& v1) {
    int tid = threadIdx.x; asm volatile("" : "+v"(tid));
    const int wid = __builtin_amdgcn_readfirstlane(tid >> 6), lane = tid & 63, fr = lane & 15, fq = lane >> 4;
    const int ks = K >> 3, kbeg = wid * ks;
    f32x4 acc[4][4];
#pragma unroll
    for (int m = 0; m < 4; ++m)
#pragma unroll
        for (int n = 0; n < 4; ++n) acc[m][n] = (f32x4){0.f, 0.f, 0.f, 0.f};
    const bf16_t* ap = A + (size_t)(row0 + fr) * lda + kbeg + fq * 8;
    const bf16_t* bp = Bt + (size_t)(col0 + fr) * ldb + kbeg + fq * 8;
#define MINI_LOAD(s_, kk_) do { _Pragma("unroll") for (int m = 0; m < 4; ++m) { a[s_][m][0] = *(const bf16x8*)(ap + (size_t)(m * 16) * lda + (kk_)); a[s_][m][1] = *(const bf16x8*)(ap + (size_t)(m * 16) * lda + (kk_) + 32); } \
        _Pragma("unroll") for (int n = 0; n < 4; ++n) { b[s_][n][0] = *(const bf16x8*)(bp + (size_t)(n * 16) * ldb + (kk_)); b[s_][n][1] = *(const bf16x8*)(bp + (size_t)(n * 16) * ldb + (kk_) + 32); } } while (0)
#define MINI_MMA(s_) do { _Pragma("unroll") for (int h = 0; h < 2; ++h) _Pragma("unroll") for (int m = 0; m < 4; ++m) _Pragma("unroll") for (int n = 0; n < 4; ++n) \
        acc[m][n] = __builtin_amdgcn_mfma_f32_16x16x32_bf16(b[s_][n][h], a[s_][m][h], acc[m][n], 0, 0, 0); } while (0)
    bf16x8 a[2][4][2], b[2][4][2];
    const int nst = ks >> 6;
    MINI_LOAD(0, 0); MINI_LOAD(1, 64);
    for (int i = 0; i < nst; i += 2) {
#pragma unroll
        for (int s_ = 0; s_ < 2; ++s_) {
            if (i + s_ < nst) { MINI_MMA(s_); if (i + s_ + 2 < nst) MINI_LOAD(s_, (i + s_ + 2) * 64); }
            __builtin_amdgcn_sched_barrier(0);
        }
    }
#undef MINI_LOAD
#undef MINI_MMA
    LAS float* P = (LAS float*)lds + wid * 4096;
#pragma unroll
    for (int m = 0; m < 4; ++m)
#pragma unroll
        for (int n = 0; n < 4; ++n) *(LAS f32x4*)(P + (16 * m + fr) * 64 + 16 * n + 4 * fq) = acc[m][n];
    __syncthreads();
    const LAS float* Q = (const LAS float*)lds + (tid >> 3) * 64 + (tid & 7) * 8;
    v0 = *(const LAS f32x4*)Q; v1 = *(const LAS f32x4*)(Q + 4);
#pragma unroll
    for (int w = 1; w < 8; ++w) { v0 += *(const LAS f32x4*)(Q + w * 4096); v1 += *(const LAS f32x4*)(Q + w * 4096 + 4); }
    __syncthreads();
}

struct Params {
    const float* x_prompt; const float* x_sample; const float* state_conv; const float* state_pool; const float* norm_mix; const float* w_in; const float* conv_w;
    const float* w_pool; const float* pool_scale; const float* w_br_conv; const float* w_br_pool; const float* w_o; const float* norm_ffn; const float* w_gate;
    const float* w_up; const float* w_down; const float* norm_final; float* out; unsigned char* ws;
};

__device__ __forceinline__ float wave_sum(float v) {
#pragma unroll
    for (int o = 1; o < 64; o <<= 1) v += __shfl_xor(v, o);
    return v;
}
__device__ __forceinline__ void transpose_item(const float* W, int ldw, int k0, int nsrc, bf16_t* WT, int Kd, int rdst, LAS float* scr, int lane) {
#pragma unroll 8
    for (int i = 0; i < 32; ++i) { const int kk = 2 * i + (lane >> 5); scr[kk * 33 + (lane & 31)] = __builtin_nontemporal_load(W + (size_t)(k0 + kk) * ldw + nsrc + (lane & 31)); }
    asm volatile("s_waitcnt lgkmcnt(0)" ::: "memory");
    const int c = lane & 7;
#pragma unroll
    for (int j = 0; j < 4; ++j) { const int n = (lane >> 3) + 8 * j; const LAS float* s = scr + (8 * c) * 33 + n;
        u32x4 o; o.x = cvt_pk_bf16(s[0 * 33], s[1 * 33]); o.y = cvt_pk_bf16(s[2 * 33], s[3 * 33]); o.z = cvt_pk_bf16(s[4 * 33], s[5 * 33]); o.w = cvt_pk_bf16(s[6 * 33], s[7 * 33]);
        *(u32x4*)(WT + (size_t)(rdst + n) * Kd + k0 + 8 * c) = o; }
    asm volatile("s_waitcnt lgkmcnt(0)" ::: "memory");
}

#define FRESH_IDS int tid_ = threadIdx.x; asm volatile("" : "+v"(tid_)); const int lane = tid_ & 63, wave = __builtin_amdgcn_readfirstlane(tid_ >> 6); \
    const int G_ = gridDim.x, bx_ = blockIdx.x, vcu_ = (G_ % 8 == 0) ? (bx_ % 8) * (G_ / 8) + bx_ / 8 : bx_, gw = vcu_ * NWAVES + wave, NGW = G_ * NWAVES; (void)wave; (void)lane
__device__ __forceinline__ void phase0(const Params& p, LAS unsigned char* lds) {
    FRESH_IDS;
    LAS float* scr = (LAS float*)(lds + wave * 16384);
    unsigned char* ws = p.ws;
    constexpr int I_IN = (DM / 64) * (DIN / 32), I_GU = I_IN, I_DN = (DFF / 64) * (DM / 32), I_BC = (DM / 64) * (DM / 32), I_O = I_BC, I_BP = (DPOOL / 64) * (DM / 32), I_PL = 4 * 4 * 8;
    constexpr int NITEMS = I_IN + I_GU + I_DN + I_BC + I_O + I_BP + I_PL;
    for (int it = gw; it < NITEMS; it += NGW) {
        int r = it;
        if (r < I_IN) { const int nblk = DIN / 32, kb = r / nblk, nd = (r % nblk) * 32;
            int ns; if (nd < 4096) { const int tile = nd >> 8, half = (nd >> 7) & 1, idx = nd & 127; ns = (half ? C_C : C_H) + 128 * tile + idx; } else if (nd < 6144) ns = nd - 2048; else ns = nd;
            transpose_item(p.w_in, DIN, kb * 64, ns, (bf16_t*)(ws + WS_WIN), DM, nd, scr, lane); continue; }
        r -= I_IN;
        if (r < I_GU) { const int nblk = DIN / 32, kb = r / nblk, nd = (r % nblk) * 32; const int tile = nd >> 8, half = (nd >> 7) & 1, idx = nd & 127;
            transpose_item(half ? p.w_up : p.w_gate, DFF, kb * 64, 128 * tile + idx, (bf16_t*)(ws + WS_WGU), DM, nd, scr, lane); continue; }
        r -= I_GU;
        if (r < I_DN) { const int nblk = DM / 32, kb = r / nblk, nd = (r % nblk) * 32; transpose_item(p.w_down, DM, kb * 64, nd, (bf16_t*)(ws + WS_WDN), DFF, nd, scr, lane); continue; }
        r -= I_DN;
        if (r < I_BC) { const int nblk = DM / 32, kb = r / nblk, nd = (r % nblk) * 32; transpose_item(p.w_br_conv, DM, kb * 64, nd, (bf16_t*)(ws + WS_WBC), DM, nd, scr, lane); continue; }
        r -= I_BC;
        if (r < I_O) { const int nblk = DM / 32, kb = r / nblk, nd = (r % nblk) * 32; transpose_item(p.w_o, DM, kb * 64, nd, (bf16_t*)(ws + WS_WO), DM, nd, scr, lane); continue; }
        r -= I_O;
        if (r < I_BP) { const int nblk = DM / 32, kb = r / nblk, nd = (r % nblk) * 32; transpose_item(p.w_br_pool, DM, kb * 64, nd, (bf16_t*)(ws + WS_WBP), DPOOL, nd, scr, lane); continue; }
        r -= I_BP;
        { const int g = r / 32, q = r % 32, kb = q / 8, nd = (q % 8) * 32; transpose_item(p.w_pool + (size_t)g * 65536, 256, kb * 64, nd, (bf16_t*)(ws + WS_WPL) + (size_t)g * 65536, 256, nd, scr, lane); }
    }
    bf16_t* XN = (bf16_t*)(ws + WS_XN);
    for (int row = gw; row < MT; row += NGW) {
        const float* xr = (row < MP) ? p.x_prompt + (size_t)row * DM : p.x_sample + (size_t)(row - MP) * DM;
        f32x4 v[8]; float s = 0.f;
#pragma unroll
        for (int j = 0; j < 8; ++j) { v[j] = __builtin_nontemporal_load((const f32x4*)xr + 64 * j + lane); s += dot4(v[j]); }
        const float rr = 1.0f / sqrtf(wave_sum(s) * (1.0f / DM) + EPS);
#pragma unroll
        for (int j = 0; j < 8; ++j) { const f32x4 g = ((const f32x4*)p.norm_mix)[64 * j + lane]; const f32x4 o = v[j] * rr * g;
            u32x2 w; w.x = cvt_pk_bf16(o[0], o[1]); w.y = cvt_pk_bf16(o[2], o[3]); ((u32x2*)(XN + (size_t)row * DM))[64 * j + lane] = w; }
    }
}

__device__ __forceinline__ void phase2(const Params& p, const bool st) {
    FRESH_IDS;
    unsigned char* ws = p.ws;
    const bf16_t* U = (const bf16_t*)(ws + WS_U); bf16_t* Bb = (bf16_t*)(ws + WS_B); const bf16_t* V = (const bf16_t*)(ws + WS_V); bf16_t* PO = (bf16_t*)(ws + WS_PO);
    const f32x4 z4 = (f32x4){0.f, 0.f, 0.f, 0.f};
    constexpr int SEG = 32, NSEG = MP / SEG, NPT = NSEG * 6;
    for (int task = gw; task < NPT; task += NGW) {
        const int seg = task / 6, ch = task % 6, r0 = seg * SEG, t0 = r0 % SEQ;
        if (ch < 4) {
            const int j = ch * 512 + lane * 8;
            const float* cw = p.conv_w + j;
            const f32x4 c0a = *(const f32x4*)cw, c0b = *(const f32x4*)(cw + 4), c1a = *(const f32x4*)(cw + DM), c1b = *(const f32x4*)(cw + DM + 4), c2a = *(const f32x4*)(cw + 2 * DM), c2b = *(const f32x4*)(cw + 2 * DM + 4);
            f32x4 u1a = z4, u1b = z4, u2a = z4, u2b = z4;
            if (t0 >= 2) { const u32x4 w1 = *(const u32x4*)(U + (size_t)(r0 - 1) * DM + j), w2 = *(const u32x4*)(U + (size_t)(r0 - 2) * DM + j); u1a = unpack_lo(w1); u1b = unpack_hi(w1); u2a = unpack_lo(w2); u2b = unpack_hi(w2); }
            for (int i = 0; i < SEG; i += 8) {
                u32x4 uw[8], bw[8];
#pragma unroll
                for (int q = 0; q < 8; ++q) { uw[q] = __builtin_nontemporal_load((const u32x4*)(U + (size_t)(r0 + i + q) * DM + j)); bw[q] = __builtin_nontemporal_load((const u32x4*)(Bb + (size_t)(r0 + i + q) * DM + j)); }
#pragma unroll
                for (int q = 0; q < 8; ++q) { const f32x4 u0a = unpack_lo(uw[q]), u0b = unpack_hi(uw[q]);
                    const f32x4 ra = unpack_lo(bw[q]) * (c0a * u2a + c1a * u1a + c2a * u0a), rb = unpack_hi(bw[q]) * (c0b * u2b + c1b * u1b + c2b * u0b);
                    if (st) *(u32x4*)(Bb + (size_t)(r0 + i + q) * DM + j) = pack8(ra, rb);
                    u2a = u1a; u2b = u1b; u1a = u0a; u1b = u0b; }
            }
        } else {
            const int j = (ch - 4) * 512 + lane * 8, g = j >> 8, w = 2 << g;
            f32x4 sa = z4, sb = z4;
            for (int k = 1; k < 16; ++k) if (k < w && t0 - k >= 0) { const u32x4 x = *(const u32x4*)(V + (size_t)(r0 - k) * DPOOL + j); sa += unpack_lo(x); sb += unpack_hi(x); }
            for (int i = 0; i < SEG; i += 8) {
                u32x4 vw[8], ow[8];
#pragma unroll
                for (int q = 0; q < 8; ++q) { const int t = t0 + i + q; vw[q] = *(const u32x4*)(V + (size_t)(r0 + i + q) * DPOOL + j);
                    ow[q] = (t - w + 1 >= 0) ? *(const u32x4*)(V + (size_t)(r0 + i + q - w + 1) * DPOOL + j) : (u32x4){0u, 0u, 0u, 0u}; }
#pragma unroll
                for (int q = 0; q < 8; ++q) { const int t = t0 + i + q; const f32x4 va = unpack_lo(vw[q]), vb = unpack_hi(vw[q]);
                    sa += va; sb += vb;
                    const float inv = 1.0f / (float)((t + 1) < w ? (t + 1) : w);
                    if (st) *(u32x4*)(PO + (size_t)(r0 + i + q) * DPOOL + j) = pack8(sa * inv - va, sb * inv - vb);
                    sa -= unpack_lo(ow[q]); sb -= unpack_hi(ow[q]); }
            }
        }
    }
    for (int it = (gw + NGW - (NPT % NGW)) % NGW; it < MS * 6; it += NGW) {
        const int row = MP + it / 6, ch = it % 6; const int rs = row - MP, b = rs / DSEQ, t = rs % DSEQ;
        if (ch < 4) {
            const int j = ch * 512 + lane * 8;
            const u32x4 w0 = *(const u32x4*)(U + (size_t)row * DM + j);
            f32x4 u0a = unpack_lo(w0), u0b = unpack_hi(w0), u1a, u1b, u2a, u2b;
            if (t >= 1) { const u32x4 w = *(const u32x4*)(U + (size_t)(row - 1) * DM + j); u1a = unpack_lo(w); u1b = unpack_hi(w); }
            else { const float* s = p.state_conv + ((size_t)b * 2 + 1) * DM + j; u1a = *(const f32x4*)s; u1b = *(const f32x4*)(s + 4); }
            if (t >= 2) { const u32x4 w = *(const u32x4*)(U + (size_t)(row - 2) * DM + j); u2a = unpack_lo(w); u2b = unpack_hi(w); }
            else { const float* s = p.state_conv + ((size_t)b * 2 + t) * DM + j; u2a = *(const f32x4*)s; u2b = *(const f32x4*)(s + 4); }
            const float* cw = p.conv_w + j;
            const f32x4 c0a = *(const f32x4*)cw, c0b = *(const f32x4*)(cw + 4), c1a = *(const f32x4*)(cw + DM), c1b = *(const f32x4*)(cw + DM + 4), c2a = *(const f32x4*)(cw + 2 * DM), c2b = *(const f32x4*)(cw + 2 * DM + 4);
            const u32x4 bw = *(const u32x4*)(Bb + (size_t)row * DM + j);
            const f32x4 ra = unpack_lo(bw) * (c0a * u2a + c1a * u1a + c2a * u0a), rb = unpack_hi(bw) * (c0b * u2b + c1b * u1b + c2b * u0b);
            if (st) *(u32x4*)(Bb + (size_t)row * DM + j) = pack8(ra, rb);
        } else {
            const int j = (ch - 4) * 512 + lane * 8, g = j >> 8, w = 2 << g;
            f32x4 sa = z4, sb = z4, va = z4, vb = z4;
            for (int k = 0; k < 16; ++k) {
                if (k < w) {
                    const int tt = t - k;
                    if (tt >= 0) { const u32x4 x = *(const u32x4*)(V + (size_t)(row - k) * DPOOL + j); const f32x4 a = unpack_lo(x), c = unpack_hi(x); sa += a; sb += c; if (k == 0) { va = a; vb = c; } }
                    else { const float* s = p.state_pool + ((size_t)b * 15 + (15 + tt)) * DPOOL + j; sa += *(const f32x4*)s; sb += *(const f32x4*)(s + 4); }
                }
            }
            const float inv = 1.0f / (float)w;
            if (st) *(u32x4*)(PO + (size_t)row * DPOOL + j) = pack8(sa * inv - va, sb * inv - vb);
        }
    }
    if (!st) return;
    float* o_cp = p.out + (size_t)MT * DM; float* o_pp = o_cp + NB * 2 * DM; float* o_cs = o_pp + NB * 15 * DPOOL; float* o_ps = o_cs + DBATCH * 2 * DM;
    const int tid = gw * 64 + lane, nth = NGW * 64;
    constexpr int N_CP = NB * 2 * DM / 8, N_PP = NB * 15 * DPOOL / 8, N_CS = DBATCH * 2 * DM / 8, N_PS = DBATCH * 15 * DPOOL / 8;
    for (int i = tid; i < N_CP + N_PP + N_CS + N_PS; i += nth) {
        int r = i; const bf16_t* src = nullptr; const float* fsrc = nullptr; float* dst;
        if (r < N_CP) { const int j8 = r % 256, ii = (r / 256) % 2, b = r / 512; src = U + (size_t)(b * SEQ + SEQ - 2 + ii) * DM + j8 * 8; dst = o_cp + (size_t)r * 8; }
        else if ((r -= N_CP) < N_PP) { const int j8 = r % 128, ii = (r / 128) % 15, b = r / 1920; src = V + (size_t)(b * SEQ + SEQ - 15 + ii) * DPOOL + j8 * 8; dst = o_pp + (size_t)r * 8; }
        else if ((r -= N_PP) < N_CS) { const int j8 = r % 256, ii = (r / 256) % 2, b = r / 512; src = U + (size_t)(MP + b * DSEQ + DSEQ - 2 + ii) * DM + j8 * 8; dst = o_cs + (size_t)r * 8; }
        else { r -= N_CS; const int j8 = r % 128, ii = (r / 128) % 15, b = r / 1920; dst = o_ps + (size_t)r * 8;
            if (ii <= 10) fsrc = p.state_pool + ((size_t)b * 15 + 4 + ii) * DPOOL + j8 * 8; else src = V + (size_t)(MP + b * DSEQ + ii - 11) * DPOOL + j8 * 8; }
        f32x4 a, c;
        if (fsrc) { a = *(const f32x4*)fsrc; c = *(const f32x4*)(fsrc + 4); } else { const u32x4 x = *(const u32x4*)src; a = unpack_lo(x); c = unpack_hi(x); }
        *(f32x4*)dst = a; *(f32x4*)(dst + 4) = c;
    }
}

__device__ __forceinline__ void phase8(const Params& p, const bool st) {
    FRESH_IDS;
    const float* ssq2 = (const float*)(p.ws + WS_CTL + 65536); const bf16_t* XB = (const bf16_t*)(p.ws + WS_SGC); const float* PART = (const float*)(p.ws + WS_WIN);
    for (int row = gw; row < MT; row += NGW) {
        f32x4* yr = (f32x4*)(p.out + (size_t)row * DM);
        const u32x4* xr = (const u32x4*)(XB + (size_t)row * DM);
        f32x4 v[8];
#pragma unroll
        for (int j = 0; j < 4; ++j) { const u32x4 x = __builtin_nontemporal_load(xr + 64 * j + lane); v[2 * j] = unpack_lo(x); v[2 * j + 1] = unpack_hi(x); }
        float rr;
        if (row < MP) rr = 1.0f / sqrtf(ssq2[row] * (1.0f / DM) + EPS);
        else {
            for (int sl = 0; sl < DFF / 512; ++sl) { const f32x4* pr = (const f32x4*)(PART + ((size_t)sl * MS + (row - MP)) * DM);
#pragma unroll
                for (int j = 0; j < 4; ++j) { const int e = (64 * j + lane) * 2; v[2 * j] += __builtin_nontemporal_load(pr + e); v[2 * j + 1] += __builtin_nontemporal_load(pr + e + 1); } }
            float s = 0.f;
#pragma unroll
            for (int j = 0; j < 8; ++j) s += dot4(v[j]);
            rr = 1.0f / sqrtf(wave_sum(s) * (1.0f / DM) + EPS);
        }
#pragma unroll
        for (int j = 0; j < 4; ++j) { const int e = (64 * j + lane) * 2; const f32x4 g0 = ((const f32x4*)p.norm_final)[e], g1 = ((const f32x4*)p.norm_final)[e + 1];
            const f32x4 o0 = v[2 * j] * rr * g0, o1 = v[2 * j + 1] * rr * g1; if (st) { __builtin_nontemporal_store(o0, yr + e); __builtin_nontemporal_store(o1, yr + e + 1); } }
    }
}

#define XB_TMO      128
#define XB_XCNT(j)  (256  + 64 * (j))
#define XB_XSUB(j)  (1280 + 64 * (j))
#define XB_XGEN(j)  (2304 + 64 * (j))
#define XB_TOP      3328
#define XB_TOPGEN   3392
#define XCD_BAR_WORDS 3456
#define XB_SPIN_CAP (1u << 18)
__device__ __forceinline__ unsigned xb_ld(unsigned* p)              { return __hip_atomic_load(p, __ATOMIC_RELAXED, __HIP_MEMORY_SCOPE_AGENT); }
__device__ __forceinline__ unsigned xb_add(unsigned* p, unsigned v) { return __hip_atomic_fetch_add(p, v, __ATOMIC_RELAXED, __HIP_MEMORY_SCOPE_AGENT); }
__device__ __forceinline__ unsigned xb_xcc_id() { return (unsigned)__builtin_amdgcn_s_getreg((3 << 11) | 20) & 0xFu; }
#define XB_SPIN(cond, bar) do { unsigned _sp = 0; while (cond) { __builtin_amdgcn_s_sleep(1); \
    if ((++_sp & 255u) == 0u) { if (xb_ld(&(bar)[XB_TMO])) break; if (_sp > XB_SPIN_CAP) { atomicAdd(&(bar)[XB_TMO], 1u); break; } } } } while (0)
struct XcdBarrier { unsigned* bar; unsigned x; volatile LAS unsigned* st; };
__device__ __forceinline__ XcdBarrier xcd_barrier_post(unsigned* bar, volatile LAS unsigned* st) {
    XcdBarrier b; b.bar = bar; b.x = xb_xcc_id(); b.st = st;
    if (threadIdx.x == 0) (void)xb_add(&bar[XB_XCNT(b.x)], 1u);
    return b;
}
__device__ __forceinline__ void xcd_barrier_complete(unsigned* bar, unsigned x, unsigned& nloc, unsigned& nx) {
    const unsigned G = gridDim.x * gridDim.y * gridDim.z;
    unsigned sum, cnt, mine, sp = 0u;
    for (;;) {
        sum = 0u; cnt = 0u; mine = 0u;
#pragma unroll
        for (unsigned j = 0; j < 16; ++j) { const unsigned c = xb_ld(&bar[XB_XCNT(j)]); sum += c; cnt += (c > 0u) ? 1u : 0u; mine = (j == x) ? c : mine; }
        if (sum == G) break;
        __builtin_amdgcn_s_sleep(1);
        if ((++sp & 255u) == 0u) { if (xb_ld(&bar[XB_TMO])) break; if (sp > XB_SPIN_CAP) { atomicAdd(&bar[XB_TMO], 1u); break; } }
    }
    nloc = mine > 0u ? mine : 1u; nx = cnt > 0u ? cnt : 1u;
}
__device__ __forceinline__ void xcd_barrier(const XcdBarrier& b) {
    asm volatile("s_waitcnt vmcnt(0)" ::: "memory");
    __syncthreads();
    if (threadIdx.x == 0) {
        unsigned* bar = b.bar;
        __builtin_amdgcn_s_waitcnt(0);
        unsigned nloc = b.st[0], nx = b.st[1];
        if (nloc == 0u) { xcd_barrier_complete(bar, b.x, nloc, nx); b.st[0] = nloc; b.st[1] = nx; }
        const unsigned old = xb_add(&bar[XB_XSUB(b.x)], 1u);
        const unsigned gen = old / nloc;
        if (old + 1u == (gen + 1u) * nloc) {
            __builtin_amdgcn_fence(__ATOMIC_RELEASE, "agent");
            asm volatile("s_waitcnt vmcnt(0)" ::: "memory");
            const unsigned og = xb_add(&bar[XB_TOP], 1u);
            const unsigned tg = og / nx;
            if (og + 1u == (tg + 1u) * nx) xb_add(&bar[XB_TOPGEN], 1u);
            else XB_SPIN(xb_ld(&bar[XB_TOPGEN]) == tg, bar);
            __builtin_amdgcn_fence(__ATOMIC_ACQUIRE, "agent");
            xb_add(&bar[XB_XGEN(b.x)], 1u);
            asm volatile("s_waitcnt vmcnt(0)" ::: "memory");
        } else {
            XB_SPIN(xb_ld(&bar[XB_XGEN(b.x)]) == gen, bar);
            __builtin_amdgcn_fence(__ATOMIC_ACQUIRE, "agent");
            asm volatile("s_waitcnt vmcnt(0)" ::: "memory");
        }
    }
    __syncthreads();
}

__global__ void __launch_bounds__(NWAVES * 64, 2) fwd_mega(Params p) {
    extern __shared__ __attribute__((aligned(16))) unsigned char lds_raw[];
    LAS unsigned char* lds = (LAS unsigned char*)lds_raw;
    cg::grid_group grid = cg::this_grid();
    const int G = gridDim.x, bx = blockIdx.x;
    unsigned char* ws = p.ws;
    if (ws == nullptr) grid.sync();
    volatile LAS unsigned* bst = (volatile LAS unsigned*)(lds + RING_BYTES + 64);
    if (threadIdx.x < 2) bst[threadIdx.x] = 0u;
    __syncthreads();
    const XcdBarrier bar = xcd_barrier_post((unsigned*)(ws + WS_BAR), bst);
#define GRID_SYNC() xcd_barrier(bar)
    float* ssq1 = (float*)(ws + WS_CTL); float* ssq2 = (float*)(ws + WS_CTL + 65536);

    for (int rep = 0; rep < REP0; ++rep) { phase0(p, lds); __syncthreads(); }
    for (int rep = 0; rep < REPS; ++rep) GRID_SYNC();
    {
        pg8::Gemm g{(const bf16_t*)(ws + WS_XN), (const bf16_t*)(ws + WS_WIN), DM, DM, DM, 0}; pg8::StaticOrder S; S.init(MT, DIN, G, bx);
        EpiG1 E{(bf16_t*)(ws + WS_U), (bf16_t*)(ws + WS_B)};
        for (int rep = 0; rep < REP1; ++rep) pg8::gemm_phase(lds, g, S, E);
    }
    GRID_SYNC();
    for (int rep = 1; rep < REP2; ++rep) phase2(p, ws == nullptr);
    phase2(p, true);
    GRID_SYNC();
    {
        pg8::Gemm g{(const bf16_t*)(ws + WS_PO), (const bf16_t*)(ws + WS_WPL), DPOOL, 256, 256, 256}; pg8::StaticOrder S; S.init(MT, DPOOL, G, bx);
        EpiPool E{(bf16_t*)(ws + WS_XN), p.pool_scale};
        for (int rep = 0; rep < REP3; ++rep) pg8::gemm_phase(lds, g, S, E);
    }
    GRID_SYNC();
    {
        pg8::StaticOrder S; S.init(MP, DM, G, bx);
        { pg8::Gemm g{(const bf16_t*)(ws + WS_B), (const bf16_t*)(ws + WS_WBC), DM, DM, DM, 0}; EpiMerge<false> E{(const bf16_t*)(ws + WS_SGC), (bf16_t*)(ws + WS_U)}; pg8::gemm_phase(lds, g, S, E); }
        { pg8::Gemm g{(const bf16_t*)(ws + WS_XN), (const bf16_t*)(ws + WS_WBP), DPOOL, DPOOL, DPOOL, 0}; EpiMerge<true> E{(const bf16_t*)(ws + WS_SGP), (bf16_t*)(ws + WS_U)}; pg8::gemm_phase(lds, g, S, E); }
        for (int u = bx; u < (MS / 64) * (DM / 64); u += G) {
            const int row0 = MP + 64 * (u >> 5), col0 = 64 * (u & 31);
            f32x4 ya0, ya1, yb0, yb1;
            mini_gemm(lds, (const bf16_t*)(ws + WS_B), DM, (const bf16_t*)(ws + WS_WBC), DM, DM, row0, col0, ya0, ya1);
            mini_gemm(lds, (const bf16_t*)(ws + WS_XN), DPOOL, (const bf16_t*)(ws + WS_WBP), DPOOL, DPOOL, row0, col0, yb0, yb1);
            const size_t off = (size_t)(row0 + (threadIdx.x >> 3)) * DM + col0 + (threadIdx.x & 7) * 8;
            const u32x4 gc = *(const u32x4*)((const bf16_t*)(ws + WS_SGC) + off), gp = *(const u32x4*)((const bf16_t*)(ws + WS_SGP) + off);
            *(u32x4*)((bf16_t*)(ws + WS_U) + off) = pack8(unpack_lo(gc) * ya0 + unpack_lo(gp) * yb0, unpack_hi(gc) * ya1 + unpack_hi(gp) * yb1);
        }
    }
    GRID_SYNC();
    {
        pg8::Gemm g{(const bf16_t*)(ws + WS_U), (const bf16_t*)(ws + WS_WO), DM, DM, DM, 0}; pg8::StaticOrder S; S.init(MP, DM, G, bx);
        EpiRes<true> E{p.x_prompt, p.x_sample, p.norm_ffn, (bf16_t*)(ws + WS_SGC), (bf16_t*)(ws + WS_XN), ssq1};
        pg8::gemm_phase(lds, g, S, E);
        for (int u = bx; u < (MS / 64) * (DM / 64); u += G) {
            const int row0 = MP + 64 * (u >> 5), col0 = 64 * (u & 31);
            f32x4 y0, y1;
            mini_gemm(lds, (const bf16_t*)(ws + WS_U), DM, (const bf16_t*)(ws + WS_WO), DM, DM, row0, col0, y0, y1);
            const int row = row0 + (threadIdx.x >> 3), col = col0 + (threadIdx.x & 7) * 8; const size_t off = (size_t)row * DM + col;
            const float* xr = p.x_sample + (size_t)(row - MP) * DM + col;
            const f32x4 a0 = *(const f32x4*)xr + y0, a1 = *(const f32x4*)(xr + 4) + y1;
            *(u32x4*)((bf16_t*)(ws + WS_SGC) + off) = pack8(a0, a1);
            const f32x4 g0 = *(const f32x4*)(p.norm_ffn + col), g1 = *(const f32x4*)(p.norm_ffn + col + 4);
            *(u32x4*)((bf16_t*)(ws + WS_XN) + off) = pack8(a0 * g0, a1 * g1);
            float sq = dot4(a0) + dot4(a1); sq += __shfl_xor(sq, 1); sq += __shfl_xor(sq, 2); sq += __shfl_xor(sq, 4);
            if ((threadIdx.x & 7) == 0) atomicAdd(ssq1 + row, sq);
        }
    }
    GRID_SYNC();
    {
        pg8::Gemm g{(const bf16_t*)(ws + WS_XN), (const bf16_t*)(ws + WS_WGU), DM, DM, DM, 0}; pg8::StaticOrder S; S.init(MT, DIN, G, bx);
        EpiFF E{(bf16_t*)(ws + WS_FF), ssq1};
        for (int rep = 0; rep < REP6; ++rep) pg8::gemm_phase(lds, g, S, E);
    }
    GRID_SYNC();
    {
        { pg8::Gemm g{(const bf16_t*)(ws + WS_FF), (const bf16_t*)(ws + WS_WDN), DFF, DFF, DFF, 0}; pg8::StaticOrder S; S.init(MP, DM, G, bx);
          EpiRes<false> E{nullptr, nullptr, nullptr, (bf16_t*)(ws + WS_SGC), nullptr, ssq2};
          pg8::gemm_phase(lds, g, S, E); }
        { pg8::Gemm g{(const bf16_t*)(ws + WS_FF), (const bf16_t*)(ws + WS_WDN), DFF, DFF, 512, 0}; pg8::SplitKOrder S{G, bx, DFF / 512, MP / BM, 1024u};
          EpiPart E{(float*)(ws + WS_WIN), 1024u};
          pg8::gemm_phase(lds, g, S, E); }
    }
    GRID_SYNC();
    for (int rep = 1; rep < REP8; ++rep) phase8(p, ws == nullptr);
    phase8(p, true);
}

extern "C" void kernel_launch(void* const* d_in, const int* in_sizes, int n_in, void* d_out, int out_size, void* d_ws, size_t ws_size, hipStream_t stream) {
    static int grid = 0;
    if (grid == 0) {
        if (n_in != 17 || ws_size < WS_END) { fprintf(stderr, "kernel_launch: unexpected n_in %d or ws_size %zu (< %zu)\n", n_in, ws_size, (size_t)WS_END); grid = -1; return; }
        int dev = 0, cus = 0, per_cu = 0;
        if (hipGetDevice(&dev) != hipSuccess || hipDeviceGetAttribute(&cus, hipDeviceAttributeMultiprocessorCount, dev) != hipSuccess) { grid = -1; return; }
        if (hipFuncSetAttribute((const void*)fwd_mega, hipFuncAttributeMaxDynamicSharedMemorySize, LDS_BYTES) != hipSuccess) { fprintf(stderr, "kernel_launch: hipFuncSetAttribute failed\n"); grid = -1; return; }
        if (hipOccupancyMaxActiveBlocksPerMultiprocessor(&per_cu, (const void*)fwd_mega, NWAVES * 64, LDS_BYTES) != hipSuccess || per_cu < 1) { fprintf(stderr, "kernel_launch: occupancy query says %d\n", per_cu); per_cu = 1; }
        (void)hipGetLastError();
        grid = cus * per_cu;
    }
    if (grid < 0) return;
    if (hipMemsetAsync((char*)d_ws + WS_CTL, 0, CTL_ZERO_BYTES, stream) != hipSuccess) { fprintf(stderr, "kernel_launch: memset failed\n"); return; }
    Params p{};
    p.x_prompt = (const float*)d_in[0]; p.x_sample = (const float*)d_in[1]; p.state_conv = (const float*)d_in[2]; p.state_pool = (const float*)d_in[3];
    p.norm_mix = (const float*)d_in[4]; p.w_in = (const float*)d_in[5]; p.conv_w = (const float*)d_in[6]; p.w_pool = (const float*)d_in[7];
    p.pool_scale = (const float*)d_in[8]; p.w_br_conv = (const float*)d_in[9]; p.w_br_pool = (const float*)d_in[10]; p.w_o = (const float*)d_in[11];
    p.norm_ffn = (const float*)d_in[12]; p.w_gate = (const float*)d_in[13]; p.w_up = (const float*)d_in[14]; p.w_down = (const float*)d_in[15];
    p.norm_final = (const float*)d_in[16]; p.out = (float*)d_out; p.ws = (unsigned char*)d_ws;
    void* args[] = {&p};
    hipError_t e = hipLaunchCooperativeKernel((const void*)fwd_mega, dim3(grid), dim3(NWAVES * 64), args, LDS_BYTES, stream);
    if (e != hipSuccess) fprintf(stderr, "kernel_launch: cooperative launch failed: %s (grid %d)\n", hipGetErrorString(e), grid);
}
```
